# Optimizing an MI355X kernel written in HIP

```python
import math
import jax, jax.numpy as jnp
from jax import lax
import numpy as np

D_MODEL = 1024
BATCH = 1
SEQ = 16384
DEPTH = 4

GRID_W = 64
CTX_LEN = 256
N_MIXERS = 4
N_GM = (DEPTH + 3) // 4
N_AT = (DEPTH + 2) // 4
N_HY = (DEPTH + 1) // 4
N_SSD = DEPTH // 4
NORM_EPS = 1e-6
FFN_HIDDEN = -(-8 * D_MODEL // (3 * 256)) * 256

GM_CHUNK = 128
GM_WIDTH = 2 * D_MODEL
GM_GROUPS = 8

AT_HEAD_DIM = 64
AT_Q_HEADS = D_MODEL // AT_HEAD_DIM
AT_KV_HEADS = 4
AT_Q_BLOCK = 128
ROPE_THETA = 10000.0

HY_ORDER = 2
HY_SHORT = 3
HY_BANDS = 16
HY_EMB = 1 + 2 * HY_BANDS
HY_FILT_W = 64
HY_FILT_OUT = 2 * (HY_ORDER - 1) * D_MODEL
HY_TARGET = 1e-2
HY_FAST_PCT = 0.3
HY_SLOW_PCT = 1.5
HY_MAX_DECAY = math.log(HY_TARGET) / HY_FAST_PCT
HY_MIN_DECAY = math.log(HY_TARGET) / HY_SLOW_PCT

SSD_INNER = 2 * D_MODEL
SSD_HEAD_DIM = 64
SSD_HEADS = SSD_INNER // SSD_HEAD_DIM
SSD_GROUPS = 4
SSD_STATE = 128
SSD_CONV = 3
SSD_CHUNK = 128
SSD_CONV_DIM = SSD_INNER + 2 * SSD_GROUPS * SSD_STATE
SSD_PROJ = SSD_INNER + SSD_CONV_DIM + 2 * SSD_HEADS

kernel_name = "hybrid_interleaved_dit_trunk"

F32 = jnp.float32


def rms_norm(x, g):
    xf = x.astype(F32)
    y = xf * lax.rsqrt(jnp.mean(xf * xf, axis=-1, keepdims=True) + NORM_EPS)
    return (y * g.astype(F32)).astype(x.dtype)


def layer_norm(x, g, b):
    xf = x.astype(F32)
    mu = jnp.mean(xf, axis=-1, keepdims=True)
    var = jnp.mean(jnp.square(xf - mu), axis=-1, keepdims=True)
    y = (xf - mu) * lax.rsqrt(var + NORM_EPS) * g.astype(F32) + b.astype(F32)
    return y.astype(x.dtype)


def modulate(h, shift, scale):
    return h * (1.0 + scale) + shift


def dwconv_centred(x, w, b):
    K = w.shape[0]
    L = x.shape[1]
    pad = K // 2
    xp = jnp.pad(x, ((0, 0), (pad, pad), (0, 0)))
    return sum(xp[:, k:k + L] * w[k] for k in range(K)) + b


def swiglu(h, w_in, w_out):
    g, u = jnp.split(h @ w_in, 2, axis=-1)
    return (jax.nn.silu(g) * u) @ w_out


def gmlp_mixer(h, w_in, ln_g, ln_b, ws, bs, w_out):
    B_, L, _ = h.shape
    u, v = jnp.split(jax.nn.gelu(h @ w_in, approximate=False), 2, axis=-1)
    v = layer_norm(v, ln_g, ln_b)
    v = v.reshape(B_, L // GM_CHUNK, GM_CHUNK, GM_GROUPS, GM_WIDTH // GM_GROUPS)
    v = jnp.einsum('gpq,bnqgc->bnpgc', ws, v) + bs.T[None, None, :, :, None]
    return (u * v.reshape(B_, L, GM_WIDTH)) @ w_out


def axial_rope(L):
    rows = L // GRID_W
    row = jnp.repeat(jnp.arange(rows, dtype=F32), GRID_W)
    col = jnp.tile(jnp.arange(GRID_W, dtype=F32), rows)
    n = AT_HEAD_DIM // 4
    inv = ROPE_THETA ** (-jnp.arange(n, dtype=F32) / n)
    ang = jnp.concatenate([row[:, None] * inv, col[:, None] * inv], axis=-1)
    return jnp.cos(ang), jnp.sin(ang)


def apply_rope(x, cos, sin):
    half = x.shape[-1] // 2
    x1, x2 = x[..., :half], x[..., half:]
    cs = cos[None, :, None, :].astype(x.dtype)
    sn = sin[None, :, None, :].astype(x.dtype)
    return jnp.concatenate([x1 * cs - x2 * sn, x2 * cs + x1 * sn], axis=-1)


def block_attention(q, k, v):
    B_, Lq = q.shape[:2]
    G = AT_Q_HEADS // AT_KV_HEADS
    nb = Lq // AT_Q_BLOCK
    qb = q.reshape(B_, nb, AT_Q_BLOCK, AT_KV_HEADS, G, AT_HEAD_DIM).transpose(1, 0, 2, 3, 4, 5)
    scale = AT_HEAD_DIM ** -0.5

    def one_block(qi):
        s = jnp.einsum('bqkgd,bskd->bkgqs', qi, k, preferred_element_type=F32) * scale
        p = jax.nn.softmax(s, axis=-1).astype(v.dtype)
        return jnp.einsum('bkgqs,bskd->bqkgd', p, v)

    o = lax.map(one_block, qb)
    return o.transpose(1, 0, 2, 3, 4, 5).reshape(B_, Lq, AT_Q_HEADS, AT_HEAD_DIM)


def attention_mixer(h_lat, h_ctx, w_qkv, q_g, k_g, w_out, want_ctx):
    def project(h):
        B_, L, _ = h.shape
        q, k, v = jnp.split(h @ w_qkv, [AT_Q_HEADS * AT_HEAD_DIM, (AT_Q_HEADS + AT_KV_HEADS) * AT_HEAD_DIM], axis=-1)
        q = rms_norm(q.reshape(B_, L, AT_Q_HEADS, AT_HEAD_DIM), q_g)
        k = rms_norm(k.reshape(B_, L, AT_KV_HEADS, AT_HEAD_DIM), k_g)
        return q, k, v.reshape(B_, L, AT_KV_HEADS, AT_HEAD_DIM)

    B_, L, _ = h_lat.shape
    q_l, k_l, v_l = project(h_lat)
    cos, sin = axial_rope(L)
    q_l, k_l = apply_rope(q_l, cos, sin), apply_rope(k_l, cos, sin)
    q_c, k_c, v_c = project(h_ctx)
    k_all = jnp.concatenate([k_c, k_l], axis=1)
    v_all = jnp.concatenate([v_c, v_l], axis=1)
    y_l = block_attention(q_l, k_all, v_all).reshape(B_, L, AT_Q_HEADS * AT_HEAD_DIM) @ w_out
    y_c = None
    if want_ctx:
        y_c = block_attention(q_c, k_c, v_c).reshape(B_, h_ctx.shape[1], AT_Q_HEADS * AT_HEAD_DIM) @ w_out
    return y_l, y_c


def hyena_filters(L, w1, b1, w2, b2, w3, freq):
    t_idx = jnp.arange(L, dtype=F32)
    t = t_idx / (L - 1)
    w = 2.0 * math.pi * t_idx / L
    f = jnp.linspace(1e-4, HY_BANDS - 1, HY_BANDS, dtype=F32)
    zf = w[:, None] * f[None, :]
    feats = jnp.concatenate([t[:, None], jnp.cos(zf), -jnp.sin(zf)], axis=-1)
    freq = freq.astype(F32)
    hid = jnp.sin(freq * (feats @ w1.astype(F32) + b1.astype(F32)))
    hid = jnp.sin(freq * (hid @ w2.astype(F32) + b2.astype(F32)))
    k = hid @ w3.astype(F32)
    deltas = jnp.abs(jnp.linspace(HY_MIN_DECAY, HY_MAX_DECAY, D_MODEL, dtype=F32))
    decay = jnp.exp(-t[:, None] * jnp.tile(deltas, 2)[None, :])
    return k * decay


def hyena_mixer(h, w_in, conv_w, conv_b, w1, b1, w2, b2, w3, freq, skip, w_out):
    B_, L, D = h.shape
    p = dwconv_centred(h @ w_in, conv_w, conv_b)
    x0, x1, v = jnp.split(p, 3, axis=-1)
    k = hyena_filters(L, w1, b1, w2, b2, w3, freq)
    k_circ = jnp.concatenate([k[:, :D], jnp.zeros((1, D), F32), jnp.flip(k[1:, D:], axis=0)], axis=0)
    u = (x1 * v).astype(F32)
    n = 2 * L
    y = jnp.fft.irfft(jnp.fft.rfft(u, n=n, axis=1) * jnp.fft.rfft(k_circ, n=n, axis=0)[None], n=n, axis=1)[:, :L]
    y = y + u * skip.astype(F32)
    return (x0 * y.astype(h.dtype)) @ w_out


def ssd_scan(x, dt, A, bm, cm, h0, need_y):
    B_, L = x.shape[:2]
    Q, G, R = SSD_CHUNK, SSD_GROUPS, SSD_HEADS // SSD_GROUPS
    nc = L // Q
    xf = x.astype(F32).reshape(B_, nc, Q, G, R, SSD_HEAD_DIM)
    dtf = dt.reshape(B_, nc, Q, G, R)
    bf = bm.astype(F32).reshape(B_, nc, Q, G, SSD_STATE)
    cf = cm.astype(F32).reshape(B_, nc, Q, G, SSD_STATE)
    acs = jnp.cumsum(dtf * A.reshape(G, R), axis=2)
    last = acs[:, :, -1]
    w_end = jnp.exp(last[:, :, None] - acs) * dtf
    states = jnp.einsum('bcjgn,bcjgr,bcjgrp->bcgrpn', bf, w_end, xf)

    def step(h, inp):
        st, dec = inp
        return h * jnp.exp(dec)[..., None, None] + st, h

    h_fin, h_start = lax.scan(step, h0, (jnp.moveaxis(states, 1, 0), jnp.moveaxis(last, 1, 0)))
    if not need_y:
        return None, h_fin
    h_start = jnp.moveaxis(h_start, 0, 1)
    order = jnp.tril(jnp.ones((Q, Q), bool))
    seg = acs[:, :, :, None] - acs[:, :, None, :]
    lmat = jnp.exp(jnp.where(order[:, :, None, None], seg, -jnp.inf))
    cb = jnp.einsum('bcign,bcjgn->bcijg', cf, bf)
    y_diag = jnp.einsum('bcijgr,bcjgrp->bcigrp', cb[..., None] * lmat * dtf[:, :, None], xf)
    y_off = jnp.einsum('bcign,bcgrpn->bcigrp', cf, h_start) * jnp.exp(acs)[..., None]
    return (y_diag + y_off).reshape(B_, L, SSD_HEADS, SSD_HEAD_DIM), h_fin


def ssd_mixer(h_lat, h_ctx, w_in, conv_w, conv_b, a_log, dt_bias, d_skip, norm_g, w_out, want_ctx):
    A = -jnp.exp(a_log.astype(F32))

    def prep(h):
        B_, L, _ = h.shape
        zg, xbc, dt = jnp.split(h @ w_in, [SSD_INNER, SSD_INNER + SSD_CONV_DIM], axis=-1)
        xbc = jax.nn.silu(dwconv_centred(xbc, conv_w, conv_b))
        xs, bm, cm = jnp.split(xbc, [SSD_INNER, SSD_INNER + SSD_GROUPS * SSD_STATE], axis=-1)
        dt = jax.nn.softplus(dt.reshape(B_, L, 2, SSD_HEADS).astype(F32) + dt_bias.astype(F32))
        return (zg, xs.reshape(B_, L, SSD_HEADS, SSD_HEAD_DIM),
                bm.reshape(B_, L, SSD_GROUPS, SSD_STATE), cm.reshape(B_, L, SSD_GROUPS, SSD_STATE), dt)

    z_l, x_l, b_l, c_l, dt_l = prep(h_lat)
    z_c, x_c, b_c, c_c, dt_c = prep(h_ctx)
    B_ = h_lat.shape[0]
    h0 = jnp.zeros((B_, SSD_GROUPS, SSD_HEADS // SSD_GROUPS, SSD_HEAD_DIM, SSD_STATE), F32)
    y_l, y_c = 0.0, 0.0
    for d in range(2):
        fl = (lambda t: jnp.flip(t, axis=1)) if d == 1 else (lambda t: t)
        yc_d, s_ctx = ssd_scan(fl(x_c), fl(dt_c[:, :, d]), A[d], fl(b_c), fl(c_c), h0, want_ctx)
        yl_d, _ = ssd_scan(fl(x_l), fl(dt_l[:, :, d]), A[d], fl(b_l), fl(c_l), s_ctx, True)
        y_l = y_l + fl(yl_d)
        if want_ctx:
            y_c = y_c + fl(yc_d)

    def finish(y, xs, zg):
        B2, L = xs.shape[:2]
        y = (y + xs.astype(F32) * d_skip.astype(F32)[:, None]).reshape(B2, L, SSD_INNER).astype(zg.dtype)
        y = (y * jax.nn.silu(zg)).reshape(B2, L, SSD_GROUPS, SSD_INNER // SSD_GROUPS)
        y = rms_norm(y, norm_g.reshape(SSD_GROUPS, SSD_INNER // SSD_GROUPS)).reshape(B2, L, SSD_INNER)
        return y @ w_out

    out_c = finish(y_c, x_c, z_c) if want_ctx else None
    return finish(y_l, x_l, z_l), out_c


def setup_inputs(seed: int = 0) -> dict:
    key = jax.random.key(seed)
    ks = iter(jax.random.split(key, 64))

    def nrm(shape, scale):
        return jax.random.normal(next(ks), shape, F32) * scale

    def gain(shape):
        return 1.0 + nrm(shape, 0.02)

    D = D_MODEL
    inp = {}
    inp["x"] = nrm((BATCH, SEQ, D), 1.0)
    inp["c"] = nrm((BATCH, D), 1.0)
    inp["ctx"] = nrm((BATCH, CTX_LEN, D), 1.0)
    inp["c_ctx"] = nrm((D,), 1.0)
    inp["norm1_g"] = gain((DEPTH, D))
    inp["norm2_g"] = gain((DEPTH, D))
    inp["mod_w"] = nrm((DEPTH, D, 6 * D), D ** -0.5)
    inp["mod_b"] = nrm((DEPTH, 6 * D), 0.02)
    inp["ffn_w_in"] = nrm((DEPTH, D, 2 * FFN_HIDDEN), D ** -0.5)
    inp["ffn_w_out"] = nrm((DEPTH, FFN_HIDDEN, D), FFN_HIDDEN ** -0.5)
    inp["final_g"] = gain((D,))
    inp["gm_w_in"] = nrm((N_GM, D, 2 * GM_WIDTH), D ** -0.5)
    inp["gm_ln_g"] = gain((N_GM, GM_WIDTH))
    inp["gm_ln_b"] = nrm((N_GM, GM_WIDTH), 0.02)
    inp["gm_ws"] = nrm((N_GM, GM_GROUPS, GM_CHUNK, GM_CHUNK), GM_CHUNK ** -0.5)
    inp["gm_bs"] = gain((N_GM, GM_GROUPS, GM_CHUNK))
    inp["gm_w_out"] = nrm((N_GM, GM_WIDTH, D), GM_WIDTH ** -0.5)
    inp["at_w_qkv"] = nrm((N_AT, D, (AT_Q_HEADS + 2 * AT_KV_HEADS) * AT_HEAD_DIM), D ** -0.5)
    inp["at_q_g"] = gain((N_AT, AT_HEAD_DIM))
    inp["at_k_g"] = gain((N_AT, AT_HEAD_DIM))
    inp["at_w_out"] = nrm((N_AT, AT_Q_HEADS * AT_HEAD_DIM, D), (AT_Q_HEADS * AT_HEAD_DIM) ** -0.5)
    inp["hy_w_in"] = nrm((N_HY, D, (HY_ORDER + 1) * D), D ** -0.5)
    inp["hy_conv_w"] = nrm((N_HY, HY_SHORT, (HY_ORDER + 1) * D), HY_SHORT ** -0.5)
    inp["hy_conv_b"] = nrm((N_HY, (HY_ORDER + 1) * D), 0.02)
    inp["hy_filt_w1"] = nrm((N_HY, HY_EMB, HY_FILT_W), HY_EMB ** -0.5)
    inp["hy_filt_b1"] = nrm((N_HY, HY_FILT_W), 0.1)
    inp["hy_filt_w2"] = nrm((N_HY, HY_FILT_W, HY_FILT_W), HY_FILT_W ** -0.5)
    inp["hy_filt_b2"] = nrm((N_HY, HY_FILT_W), 0.1)
    inp["hy_filt_w3"] = nrm((N_HY, HY_FILT_W, HY_FILT_OUT), 0.004)
    inp["hy_filt_freq"] = gain((N_HY, HY_FILT_W))
    inp["hy_skip"] = nrm((N_HY, D), 0.5)
    inp["hy_w_out"] = nrm((N_HY, D, D), D ** -0.5)
    inp["ssd_w_in"] = nrm((N_SSD, D, SSD_PROJ), D ** -0.5)
    inp["ssd_conv_w"] = nrm((N_SSD, SSD_CONV, SSD_CONV_DIM), SSD_CONV ** -0.5)
    inp["ssd_conv_b"] = nrm((N_SSD, SSD_CONV_DIM), 0.02)
    inp["ssd_a_log"] = jnp.log(jax.random.uniform(next(ks), (N_SSD, 2, SSD_HEADS), F32, 1.0, 16.0))
    dt0 = jnp.exp(jax.random.uniform(next(ks), (N_SSD, 2, SSD_HEADS), F32, math.log(1e-3), math.log(1e-1)))
    inp["ssd_dt_bias"] = dt0 + jnp.log(-jnp.expm1(-dt0))
    inp["ssd_d_skip"] = gain((N_SSD, SSD_HEADS))
    inp["ssd_norm_g"] = gain((N_SSD, SSD_INNER))
    inp["ssd_w_out"] = nrm((N_SSD, SSD_INNER, D), SSD_INNER ** -0.5)
    return inp


def reference(x, c, ctx, c_ctx, norm1_g, norm2_g, mod_w, mod_b, ffn_w_in, ffn_w_out, final_g,
              gm_w_in, gm_ln_g, gm_ln_b, gm_ws, gm_bs, gm_w_out,
              at_w_qkv, at_q_g, at_k_g, at_w_out,
              hy_w_in, hy_conv_w, hy_conv_b, hy_filt_w1, hy_filt_b1, hy_filt_w2, hy_filt_b2,
              hy_filt_w3, hy_filt_freq, hy_skip, hy_w_out,
              ssd_w_in, ssd_conv_w, ssd_conv_b, ssd_a_log, ssd_dt_bias, ssd_d_skip, ssd_norm_g, ssd_w_out):
    z = ctx
    for i in range(DEPTH):
        m, j = i % N_MIXERS, i // N_MIXERS
        want_ctx = i < DEPTH - 1
        ctx_reads = want_ctx or m in (1, 3)
        mod_l = (jax.nn.silu(c) @ mod_w[i] + mod_b[i])[:, None, :]
        mod_c = (jax.nn.silu(c_ctx) @ mod_w[i] + mod_b[i])[None, None, :]
        sh1, sc1, g1, sh2, sc2, g2 = jnp.split(mod_l, 6, axis=-1)
        csh1, csc1, cg1, csh2, csc2, cg2 = jnp.split(mod_c, 6, axis=-1)
        h_l = modulate(rms_norm(x, norm1_g[i]), sh1, sc1)
        h_c = modulate(rms_norm(z, norm1_g[i]), csh1, csc1) if ctx_reads else None
        if m == 0:
            p = (gm_w_in[j], gm_ln_g[j], gm_ln_b[j], gm_ws[j], gm_bs[j], gm_w_out[j])
            y_l = gmlp_mixer(h_l, *p)
            y_c = gmlp_mixer(h_c, *p) if want_ctx else None
        elif m == 1:
            y_l, y_c = attention_mixer(h_l, h_c, at_w_qkv[j], at_q_g[j], at_k_g[j], at_w_out[j], want_ctx)
        elif m == 2:
            p = (hy_w_in[j], hy_conv_w[j], hy_conv_b[j], hy_filt_w1[j], hy_filt_b1[j], hy_filt_w2[j],
                 hy_filt_b2[j], hy_filt_w3[j], hy_filt_freq[j], hy_skip[j], hy_w_out[j])
            y_l = hyena_mixer(h_l, *p)
            y_c = hyena_mixer(h_c, *p) if want_ctx else None
        else:
            y_l, y_c = ssd_mixer(h_l, h_c, ssd_w_in[j], ssd_conv_w[j], ssd_conv_b[j], ssd_a_log[j],
                                 ssd_dt_bias[j], ssd_d_skip[j], ssd_norm_g[j], ssd_w_out[j], want_ctx)
        x = x + g1 * y_l
        x = x + g2 * swiglu(modulate(rms_norm(x, norm2_g[i]), sh2, sc2), ffn_w_in[i], ffn_w_out[i])
        if want_ctx:
            z = z + cg1 * y_c
            z = z + cg2 * swiglu(modulate(rms_norm(z, norm2_g[i]), csh2, csc2), ffn_w_in[i], ffn_w_out[i])
    return rms_norm(x, final_g)
```

```cpp
#include <hip/hip_runtime.h>
#include <hip/hip_cooperative_groups.h>
#include <hip/hip_bf16.h>
#include <cstdio>
#include <cstdint>
#include <cmath>
#include <utility>
namespace cg = cooperative_groups;
__device__ __forceinline__ int TIDX() { int t = threadIdx.x; asm volatile("" : "+v"(t)); return t; }
#ifndef MK_MULTI_LAUNCH
#define MK_MULTI_LAUNCH 0
#endif
__device__ __forceinline__ float silu_f(float x) { return x * __builtin_amdgcn_rcpf(1.0f + __expf(-x)); }
namespace pg8 {
#define PG8_LAS __attribute__((address_space(3)))
typedef unsigned short bf16_t;
typedef short bf16x8 __attribute__((ext_vector_type(8)));
typedef float f32x4 __attribute__((ext_vector_type(4)));
typedef unsigned u32x4 __attribute__((ext_vector_type(4)));
constexpr int BM = 256, BK = 64, HALF = 128, HTB = HALF * BK * 2  , STAGE_BYTES = 8 * HTB, NXCD = 8, WGM = 8;

__host__ __device__ __forceinline__ int lds_byte(int r, int c) { const int st = (r >> 4) * 2 + (c >> 5), rr = r & 15, cc = c & 31, ob = rr * 64 + cc * 2; return st * 1024 + (ob ^ (((ob >> 9) & 1) << 5)); }
__host__ __device__ __forceinline__ void stage_rc(int b, int& R, int& C) { const int st = b / 1024, sb = b % 1024, swz = sb ^ (((sb >> 9) & 1) << 5); R = (st >> 1) * 16 + swz / 64; C = (st & 1) * 32 + (swz % 64) / 2; }
__host__ __device__ __forceinline__ int perm32(int rho) { const int n = rho >> 4, i = rho & 15; return 8 * (i >> 2) + 4 * n + (i & 3); }

struct Unit { int pm, pn, kz; };
struct Gemm { const bf16_t* A; const bf16_t* Bt; int M, N, K, kloop; };

struct StaticOrder {
    int nM, nN, nwg, G, c;
    __host__ __device__ void init(int M, int N, int G_, int c_) { nM = M / BM; nN = N / BM; nwg = nM * nN; G = G_; c = c_; }
    __host__ __device__ bool next(int i, Unit& u) const {
        const long L = (long)i * G + c; if (L >= nwg) return false;
        int wgid = (int)L; { const int q = nwg / NXCD, r = nwg % NXCD, xcd = wgid % NXCD, off = wgid / NXCD; wgid = (xcd < r ? xcd * (q + 1) : r * (q + 1) + (xcd - r) * q) + off; }
        const int nig = WGM * nN, gid = wgid / nig, fm = gid * WGM, gsz = (nM - fm) < WGM ? (nM - fm) : WGM;
        u.pm = fm + ((wgid % nig) % gsz); u.pn = (wgid % nig) / gsz; u.kz = 0; return true;
    }
    __device__ __forceinline__ void a_ready(const Unit&) const {}
    __device__ __forceinline__ void done(const Unit&) const {}
};

__device__ __forceinline__ unsigned cvt_pk_bf16(float lo, float hi) { unsigned r; asm volatile("v_cvt_pk_bf16_f32 %0, %1, %2" : "=v"(r) : "v"(lo), "v"(hi)); return r; }
typedef float f32x2 __attribute__((ext_vector_type(2)));
__device__ __forceinline__ f32x2 gelu_pk(f32x2 v) {
    const f32x2 av = __builtin_elementwise_abs(v), d = av * 0.2316418882f + 1.0f;
    f32x2 t; t.x = __builtin_amdgcn_rcpf(d.x); t.y = __builtin_amdgcn_rcpf(d.y);
    f32x2 q = t * 0.5307027145f + (-0.7265760135f); q = q * t + 0.7107068705f; q = q * t + (-0.142248368f); q = q * t + 0.127414796f; q = q * t;
    const f32x2 s = (v * v) * (-0.72134752044f);
    f32x2 e; e.x = __builtin_amdgcn_exp2f(s.x); e.y = __builtin_amdgcn_exp2f(s.y);
    const f32x2 m = v * (q * e), r = v - m;
    f32x2 o; o.x = v.x < 0.f ? m.x : r.x; o.y = v.y < 0.f ? m.y : r.y; return o;
}

typedef unsigned u32x2 __attribute__((ext_vector_type(2)));

struct Route { bf16_t* base; int ldc; int col; };
struct RouterSimple { bf16_t* O; int ldc; __device__ __forceinline__ Route operator()(int pn) const { return Route{O, ldc, pn * BM}; } };
struct RouterGm { bf16_t* U; bf16_t* V; __device__ __forceinline__ Route operator()(int pn) const { return pn < 8 ? Route{U, 2048, pn * BM} : Route{V, 2048, (pn - 8) * BM}; } };
template <int ACT, class Router> struct EpiStore {
    static constexpr bool PERM = true, AFTER_DRAIN = false;
    Router R;
    __device__ __forceinline__ void operator()(const f32x4 (&acc)[2][2][4][2], const Unit& u, int wr, int wc, int fr, int fq) const {
        const int row0 = u.pm * BM + wr * 64 + fr; const Route rt = R(u.pn);
        const int col0 = rt.col + wc * 32 + 8 * fq;
#pragma unroll
        for (int ai = 0; ai < 2; ++ai)
#pragma unroll
            for (int m = 0; m < 4; ++m) { bf16_t* rowp = rt.base + (size_t)(row0 + ai * HALF + m * 16) * rt.ldc + col0;
#pragma unroll
                for (int bj = 0; bj < 2; ++bj) { f32x4 v0 = acc[ai][bj][m][0], v1 = acc[ai][bj][m][1];
                    if (ACT == 1) { f32x2 a = gelu_pk((f32x2){v0[0], v0[1]}), b = gelu_pk((f32x2){v0[2], v0[3]}), c = gelu_pk((f32x2){v1[0], v1[1]}), d = gelu_pk((f32x2){v1[2], v1[3]});
                        v0 = (f32x4){a.x, a.y, b.x, b.y}; v1 = (f32x4){c.x, c.y, d.x, d.y}; }
                    u32x4 w; w.x = cvt_pk_bf16(v0[0], v0[1]); w.y = cvt_pk_bf16(v0[2], v0[3]); w.z = cvt_pk_bf16(v1[0], v1[1]); w.w = cvt_pk_bf16(v1[2], v1[3]);
                    *(u32x4*)(rowp + bj * HALF) = w; } }
    }
};
struct EpiGmIn {
    static constexpr bool PERM = true, AFTER_DRAIN = false;
    bf16_t* U; bf16_t* V; float* STATS;
    __device__ __forceinline__ void operator()(const f32x4 (&acc)[2][2][4][2], const Unit& u, int wr, int wc, int fr, int fq) const {
        const int row0 = u.pm * BM + wr * 64 + fr; const bool isv = u.pn >= 8;
        bf16_t* base = isv ? V : U; const int col0 = (isv ? u.pn - 8 : u.pn) * BM + wc * 32 + 8 * fq;
#pragma unroll
        for (int ai = 0; ai < 2; ++ai)
#pragma unroll
            for (int m = 0; m < 4; ++m) { const int row = row0 + ai * HALF + m * 16; bf16_t* rowp = base + (size_t)row * 2048 + col0; float s = 0.f, q = 0.f;
#pragma unroll
                for (int bj = 0; bj < 2; ++bj) { f32x4 v0 = acc[ai][bj][m][0], v1 = acc[ai][bj][m][1];
                    f32x2 a = gelu_pk((f32x2){v0[0], v0[1]}), b = gelu_pk((f32x2){v0[2], v0[3]}), c = gelu_pk((f32x2){v1[0], v1[1]}), d = gelu_pk((f32x2){v1[2], v1[3]});
                    u32x4 w; w.x = cvt_pk_bf16(a.x, a.y); w.y = cvt_pk_bf16(b.x, b.y); w.z = cvt_pk_bf16(c.x, c.y); w.w = cvt_pk_bf16(d.x, d.y);
                    *(u32x4*)(rowp + bj * HALF) = w;
                    s += ((a.x + a.y) + (b.x + b.y)) + ((c.x + c.y) + (d.x + d.y));
                    q += ((a.x * a.x + a.y * a.y) + (b.x * b.x + b.y * b.y)) + ((c.x * c.x + c.y * c.y) + (d.x * d.x + d.y * d.y)); }
                if (isv) { s += __shfl_xor(s, 16); s += __shfl_xor(s, 32); q += __shfl_xor(q, 16); q += __shfl_xor(q, 32);
                    if (fq == 0) { float* sp = STATS + (((size_t)row * 8 + (u.pn - 8)) * 4 + wc) * 2; sp[0] = s; sp[1] = q; } } }
    }
};
struct EpiSwiglu {
    static constexpr bool PERM = true, AFTER_DRAIN = false;
    bf16_t* O;
    __device__ __forceinline__ void operator()(const f32x4 (&acc)[2][2][4][2], const Unit& u, int wr, int wc, int fr, int fq) const {
        const int row0 = u.pm * BM + wr * 64 + fr; const int col0 = u.pn * HALF + wc * 32 + 8 * fq;
#pragma unroll
        for (int ai = 0; ai < 2; ++ai)
#pragma unroll
            for (int m = 0; m < 4; ++m) { bf16_t* rowp = O + (size_t)(row0 + ai * HALF + m * 16) * 2816 + col0;
                const f32x4 g0 = acc[ai][0][m][0], g1 = acc[ai][0][m][1], u0 = acc[ai][1][m][0], u1 = acc[ai][1][m][1];
                u32x4 w; w.x = cvt_pk_bf16(silu_f(g0[0]) * u0[0], silu_f(g0[1]) * u0[1]); w.y = cvt_pk_bf16(silu_f(g0[2]) * u0[2], silu_f(g0[3]) * u0[3]);
                w.z = cvt_pk_bf16(silu_f(g1[0]) * u1[0], silu_f(g1[1]) * u1[1]); w.w = cvt_pk_bf16(silu_f(g1[2]) * u1[2], silu_f(g1[3]) * u1[3]);
                *(u32x4*)rowp = w; }
    }
};
struct EpiResid {
    static constexpr bool PERM = false, AFTER_DRAIN = false;
    float* X; const float* gate_lat; const float* gate_ctx; int ctx_tile;
    __device__ __forceinline__ void operator()(const f32x4 (&acc)[2][2][4][2], const Unit& u, int wr, int wc, int fr, int fq) const {
        const int row0 = u.pm * BM + wr * 64 + fr; const int col0 = u.pn * BM + wc * 32 + 4 * fq;
        const float* gate = (ctx_tile && u.pm == 0) ? gate_ctx : gate_lat;
        f32x4 gv[2][2];
#pragma unroll
        for (int bj = 0; bj < 2; ++bj)
#pragma unroll
            for (int n = 0; n < 2; ++n) gv[bj][n] = *(const f32x4*)(gate + col0 + bj * HALF + 16 * n);
#pragma unroll
        for (int ai = 0; ai < 2; ++ai)
#pragma unroll
            for (int m = 0; m < 4; ++m) { float* xrow = X + (size_t)(row0 + ai * HALF + m * 16) * 1024 + col0;
#pragma unroll
                for (int bj = 0; bj < 2; ++bj)
#pragma unroll
                    for (int n = 0; n < 2; ++n) { f32x4* p = (f32x4*)(xrow + bj * HALF + 16 * n); *p = *p + gv[bj][n] * acc[ai][bj][m][n]; } }
    }
};
struct SplitKOrder {
    int nN, nks, G, c;
    __host__ __device__ void init(int N, int nks_, int G_, int c_) { nN = N / BM; nks = nks_; G = G_; c = c_; }
    __host__ __device__ bool next(int i, Unit& u) const { const long L = (long)i * G + c; if (L >= (long)nN * nks) return false; u.pm = 0; u.pn = (int)(L % nN); u.kz = (int)(L / nN); return true; }
    __device__ __forceinline__ void a_ready(const Unit&) const {}
    __device__ __forceinline__ void done(const Unit&) const {}
};
struct EpiPartial {
    static constexpr bool PERM = false, AFTER_DRAIN = false;
    float* P;
    __device__ __forceinline__ void operator()(const f32x4 (&acc)[2][2][4][2], const Unit& u, int wr, int wc, int fr, int fq) const {
        const int row0 = wr * 64 + fr; const int col0 = u.pn * BM + wc * 32 + 4 * fq;
#pragma unroll
        for (int ai = 0; ai < 2; ++ai)
#pragma unroll
            for (int m = 0; m < 4; ++m) { float* prow = P + ((size_t)u.kz * 256 + row0 + ai * HALF + m * 16) * 1024 + col0;
#pragma unroll
                for (int bj = 0; bj < 2; ++bj)
#pragma unroll
                    for (int n = 0; n < 2; ++n) *(f32x4*)(prow + bj * HALF + 16 * n) = acc[ai][bj][m][n]; }
    }
};
struct EpiSsdIn {
    static constexpr bool PERM = true, AFTER_DRAIN = false;
    bf16_t* Z; bf16_t* XBC; float* DT; bf16_t* HALO;
    __device__ __forceinline__ void operator()(const f32x4 (&acc)[2][2][4][2], const Unit& u, int wr, int wc, int fr, int fq) const {
        const int row0 = u.pm * BM + wr * 64 + fr; const int pn = u.pn;
        if (pn < 20) {
            bf16_t* base = pn < 8 ? Z : XBC; const int ldc = pn < 8 ? 2048 : 3072; const int col0 = (pn < 8 ? pn : pn - 8) * BM + wc * 32 + 8 * fq;
#pragma unroll
            for (int ai = 0; ai < 2; ++ai)
#pragma unroll
                for (int m = 0; m < 4; ++m) { const int row = row0 + ai * HALF + m * 16; bf16_t* rowp = base + (size_t)row * ldc + col0; const int rl = row & 31;
#pragma unroll
                    for (int bj = 0; bj < 2; ++bj) { const f32x4 v0 = acc[ai][bj][m][0], v1 = acc[ai][bj][m][1];
                        u32x4 w; w.x = cvt_pk_bf16(v0[0], v0[1]); w.y = cvt_pk_bf16(v0[2], v0[3]); w.z = cvt_pk_bf16(v1[0], v1[1]); w.w = cvt_pk_bf16(v1[2], v1[3]);
                        *(u32x4*)(rowp + bj * HALF) = w;
                        if (pn >= 8 && (rl == 0 || rl == 31)) *(u32x4*)(HALO + ((size_t)(row >> 5) * 2 + (rl == 31 ? 1 : 0)) * 3072 + col0 + bj * HALF) = w; } }
        } else if (wc < 2) {
#pragma unroll
            for (int ai = 0; ai < 2; ++ai)
#pragma unroll
                for (int m = 0; m < 4; ++m) { float* rowp = DT + (size_t)(row0 + ai * HALF + m * 16) * 64 + wc * 32 + 8 * fq;
                    *(f32x4*)rowp = acc[ai][0][m][0]; *(f32x4*)(rowp + 4) = acc[ai][0][m][1]; }
        }
    }
};
template <class Epi, class Sched, bool ALIGN_EPI = false, bool SP2 = false>
__device__ __forceinline__ void gemm_phase(PG8_LAS unsigned char* lds, const Gemm g, const Sched& S, const Epi& E) {
    const int tid = TIDX(), wid = __builtin_amdgcn_readfirstlane(tid >> 6), lane = tid & 63, wr = wid >> 2, wc = wid & 3, fr = lane & 15, fq = lane >> 4;
    const int K = g.K, nt = g.kloop / BK; const size_t kzb = (size_t)g.kloop * 2;
    unsigned voffA[2], voffB[2];
#pragma unroll
    for (int i = 0; i < 2; ++i) { int R, C; stage_rc(tid * 16 + i * 8192, R, C); const int Rb = Epi::PERM ? ((R & ~31) + perm32(R & 31)) : R;
        voffA[i] = (unsigned)(R * K + C) * 2u; voffB[i] = (unsigned)(Rb * K + C) * 2u; }
    const size_t kstep = (size_t)(BK * 2);
    const size_t hstep = (size_t)HALF * K * 2;
    const size_t tstep = 2 * hstep;
    const unsigned ldsw = (unsigned)wid * 1024u;
    const int aoff = lds_byte(wr * 64 + fr, fq * 8), boff = lds_byte(wc * 32 + fr, fq * 8);
#define PG8_SA(b, h) (((b) * 2 + (h)) * HTB)
#define PG8_SB(b, h) ((4 + (b) * 2 + (h)) * HTB)
#define PG8_STAGE(bufoff, gbase, voff) do { _Pragma("unroll") for (int _i = 0; _i < 2; ++_i) \
        __builtin_amdgcn_global_load_lds((const unsigned*)((const char*)(gbase) + (voff)[_i]), (PG8_LAS unsigned*)(lds + (bufoff) + ldsw + _i * 8192), 16, 0, 0); } while (0)
#define PG8_LDA(dst, b, h) do { _Pragma("unroll") for (int m = 0; m < 4; ++m) _Pragma("unroll") for (int k = 0; k < 2; ++k) dst[m][k] = *(const PG8_LAS bf16x8*)(lds + PG8_SA(b, h) + aoff + m * 2048 + k * 1024); } while (0)
#define PG8_LDB(dst, b, h) do { _Pragma("unroll") for (int n = 0; n < 2; ++n) _Pragma("unroll") for (int k = 0; k < 2; ++k) dst[n][k] = *(const PG8_LAS bf16x8*)(lds + PG8_SB(b, h) + boff + n * 2048 + k * 1024); } while (0)
#define PG8_MMA(ai, bj, At, Bt) do { __builtin_amdgcn_s_setprio(1); _Pragma("unroll") for (int m = 0; m < 4; ++m) _Pragma("unroll") for (int n = 0; n < 2; ++n) _Pragma("unroll") for (int k = 0; k < 2; ++k) \
        acc[ai][bj][m][n] = __builtin_amdgcn_mfma_f32_16x16x32_bf16(Bt[n][k], At[m][k], acc[ai][bj][m][n], 0, 0, 0); __builtin_amdgcn_s_setprio(0); } while (0)
#define PG8_WAIT_V(n) asm volatile("s_waitcnt vmcnt(" #n ")" ::: "memory")
#define PG8_WAIT_L(n) asm volatile("s_waitcnt lgkmcnt(" #n ")" ::: "memory")
#define PG8_BAR __builtin_amdgcn_s_barrier()
#define PG8_SCHED __builtin_amdgcn_sched_barrier(0)
    Unit cur, nxt; int ui = 0;
    if (!S.next(0, cur)) return;
    f32x4 acc[2][2][4][2];
#pragma unroll
    for (int a = 0; a < 2; ++a)
#pragma unroll
        for (int b = 0; b < 2; ++b)
#pragma unroll
            for (int m = 0; m < 4; ++m)
#pragma unroll
                for (int n = 0; n < 2; ++n) acc[a][b][m][n] = (f32x4){0.f, 0.f, 0.f, 0.f};
    bf16x8 At[4][2], B0[2][2], B1[2][2];
    const char* cA = (const char*)g.A + (size_t)cur.pm * tstep + (size_t)cur.kz * kzb; const char* cB = (const char*)g.Bt + (size_t)cur.pn * tstep + (size_t)cur.kz * kzb;
    S.a_ready(cur);
    if constexpr (SP2) {
        PG8_STAGE(PG8_SB(0, 0), cB, voffB); PG8_STAGE(PG8_SB(0, 1), cB + hstep, voffB); PG8_STAGE(PG8_SA(0, 0), cA, voffA); PG8_STAGE(PG8_SA(0, 1), cA + hstep, voffA);
        if (wr == 1) PG8_BAR;
        PG8_WAIT_V(2); PG8_BAR;
        PG8_STAGE(PG8_SB(1, 0), cB + kstep, voffB); PG8_STAGE(PG8_SA(1, 0), cA + kstep, voffA); PG8_STAGE(PG8_SB(1, 1), cB + hstep + kstep, voffB);
        PG8_WAIT_V(6); PG8_BAR;
    } else {
        PG8_STAGE(PG8_SB(0, 0), cB, voffB); PG8_STAGE(PG8_SA(0, 0), cA, voffA); PG8_STAGE(PG8_SB(0, 1), cB + hstep, voffB); PG8_STAGE(PG8_SA(0, 1), cA + hstep, voffA);
        if (wr == 1) PG8_BAR;
        PG8_WAIT_V(4); PG8_BAR;
        PG8_STAGE(PG8_SB(1, 0), cB + kstep, voffB); PG8_STAGE(PG8_SA(1, 0), cA + kstep, voffA); PG8_STAGE(PG8_SB(1, 1), cB + hstep + kstep, voffB);
        PG8_WAIT_V(6); PG8_BAR;
    }
    for (;;) {
        const bool has_next = S.next(ui + 1, nxt);
        const char* nA = has_next ? (const char*)g.A + (size_t)nxt.pm * tstep + (size_t)nxt.kz * kzb : cA; const char* nB = has_next ? (const char*)g.Bt + (size_t)nxt.pn * tstep + (size_t)nxt.kz * kzb : cB;
        for (int t = 0; t < nt; t += 2) {
            const bool last = (t == nt - 2);
            const char* a1 = cA + (size_t)(t + 1) * kstep;
            const char* a2 = last ? nA : cA + (size_t)(t + 2) * kstep; const char* b2 = last ? nB : cB + (size_t)(t + 2) * kstep;
            const char* a3 = a2 + kstep; const char* b3 = b2 + kstep;
            if (last && has_next) S.a_ready(nxt);
            if constexpr (SP2) {
            PG8_LDB(B0, 0, 0); PG8_LDB(B1, 0, 1); PG8_SCHED; PG8_LDA(At, 0, 0); PG8_STAGE(PG8_SA(1, 1), a1 + hstep, voffA);
            PG8_WAIT_V(8); PG8_WAIT_L(0); PG8_BAR; PG8_MMA(0, 0, At, B0); PG8_MMA(0, 1, At, B1); PG8_BAR; PG8_SCHED;
            PG8_LDA(At, 0, 1); PG8_STAGE(PG8_SB(0, 0), b2, voffB); PG8_STAGE(PG8_SB(0, 1), b2 + hstep, voffB); PG8_STAGE(PG8_SA(0, 0), a2, voffA);
            PG8_WAIT_V(8); PG8_WAIT_L(0); PG8_BAR; PG8_MMA(1, 0, At, B0); PG8_MMA(1, 1, At, B1); PG8_BAR; PG8_SCHED;
            PG8_LDB(B0, 1, 0); PG8_LDB(B1, 1, 1); PG8_SCHED; PG8_LDA(At, 1, 0); PG8_STAGE(PG8_SA(0, 1), a2 + hstep, voffA);
            PG8_WAIT_V(8); PG8_WAIT_L(0); PG8_BAR; PG8_MMA(0, 0, At, B0); PG8_MMA(0, 1, At, B1); PG8_BAR; PG8_SCHED;
            PG8_LDA(At, 1, 1); PG8_STAGE(PG8_SB(1, 0), b3, voffB); PG8_STAGE(PG8_SB(1, 1), b3 + hstep, voffB); PG8_STAGE(PG8_SA(1, 0), a3, voffA);
            PG8_WAIT_V(8); PG8_WAIT_L(0); PG8_BAR; PG8_MMA(1, 0, At, B0); PG8_MMA(1, 1, At, B1); PG8_BAR; PG8_SCHED;
            } else {
            PG8_LDB(B0, 0, 0); PG8_SCHED; PG8_LDA(At, 0, 0); PG8_STAGE(PG8_SA(1, 1), a1 + hstep, voffA);
            PG8_WAIT_L(8); PG8_BAR; PG8_WAIT_L(0); PG8_MMA(0, 0, At, B0); PG8_BAR; PG8_SCHED;
            PG8_LDB(B1, 0, 1); PG8_STAGE(PG8_SB(0, 0), b2, voffB);
            PG8_BAR; PG8_WAIT_L(0); PG8_MMA(0, 1, At, B1); PG8_BAR;
            PG8_LDA(At, 0, 1); PG8_STAGE(PG8_SA(0, 0), a2, voffA);
            PG8_BAR; PG8_WAIT_L(0); PG8_MMA(1, 0, At, B0); PG8_BAR; PG8_SCHED;
            PG8_STAGE(PG8_SB(0, 1), b2 + hstep, voffB);
            PG8_WAIT_V(6); PG8_BAR; PG8_MMA(1, 1, At, B1); PG8_BAR;
            PG8_LDB(B0, 1, 0); PG8_SCHED; PG8_LDA(At, 1, 0); PG8_STAGE(PG8_SA(0, 1), a2 + hstep, voffA);
            PG8_WAIT_L(8); PG8_BAR; PG8_WAIT_L(0); PG8_MMA(0, 0, At, B0); PG8_BAR; PG8_SCHED;
            PG8_LDB(B1, 1, 1); PG8_STAGE(PG8_SB(1, 0), b3, voffB);
            PG8_BAR; PG8_WAIT_L(0); PG8_MMA(0, 1, At, B1); PG8_BAR;
            PG8_LDA(At, 1, 1); PG8_STAGE(PG8_SA(1, 0), a3, voffA);
            PG8_BAR; PG8_WAIT_L(0); PG8_MMA(1, 0, At, B0); PG8_BAR; PG8_SCHED;
            PG8_STAGE(PG8_SB(1, 1), b3 + hstep, voffB);
            PG8_WAIT_V(6); PG8_BAR; PG8_MMA(1, 1, At, B1); PG8_BAR;
            }
        }
        if constexpr (ALIGN_EPI) { if (wr == 0) PG8_BAR; }
        if constexpr (!Epi::AFTER_DRAIN) { E(acc, cur, wr, wc, fr, fq); S.done(cur); }
        if (!has_next) break;
#pragma unroll
        for (int a = 0; a < 2; ++a)
#pragma unroll
            for (int b = 0; b < 2; ++b)
#pragma unroll
                for (int m = 0; m < 4; ++m)
#pragma unroll
                    for (int n = 0; n < 2; ++n) acc[a][b][m][n] = (f32x4){0.f, 0.f, 0.f, 0.f};
        cur = nxt; cA = nA; cB = nB; ++ui;
        if constexpr (ALIGN_EPI) { if (wr == 1) PG8_BAR; }
    }
    PG8_WAIT_V(0);
    if constexpr (!ALIGN_EPI) { if (wr == 0) PG8_BAR; }
    PG8_BAR;
    if constexpr (Epi::AFTER_DRAIN) { E.fused(acc, cur, wr, wc, fr, fq, lds, wid, lane); S.done(cur); }
#undef PG8_SA
#undef PG8_SB
#undef PG8_STAGE
#undef PG8_LDA
#undef PG8_LDB
#undef PG8_MMA
#undef PG8_WAIT_V
#undef PG8_WAIT_L
#undef PG8_BAR
#undef PG8_SCHED
}
}
#include <hip/hip_bf16.h>
#include <cmath>
namespace attn_body {
using bf16=__hip_bfloat16;
using bf16x8=__attribute__((ext_vector_type(8)))short;
using s16x4=__attribute__((ext_vector_type(4)))short;
using f32x16=__attribute__((ext_vector_type(16)))float;
using u32x4=__attribute__((ext_vector_type(4)))unsigned;
constexpr int NHEAD=16,D=64,QP=1024,KP=256;
constexpr int NW=8,QBLK=32,QB=QBLK*NW,KVBLK=64;
constexpr int ATTN_UNIT_ROWS=QB;
__device__ __forceinline__ int crow(int r,int hi){return (r&3)+8*(r>>2)+4*hi;}
#define SBAR() __builtin_amdgcn_sched_barrier(0)
__device__ __forceinline__ void cmask(f32x16&p0,f32x16&p1,int jb,int qrel,int hi){
  const float NEG=-INFINITY; int kb=64*jb+4*hi;
  #pragma unroll
  for(int r=0;r<16;++r){int kv=kb+(r&3)+8*(r>>2); if(kv>qrel)p0[r]=NEG; if(kv+32>qrel)p1[r]=NEG;}
}

constexpr int NSLOT=3, SLOTB=8192;
constexpr int LDS_K=0, LDS_V=NSLOT*SLOTB, LDS_WS=2*NSLOT*SLOTB, LDS_OST=LDS_WS+NW*64*4, LDS_BYTES=LDS_OST+NW*4096;
constexpr float C2=0.125f*1.4426950408889634f;
__device__ __forceinline__ void glds16(const void*gsrc,unsigned lds_dst){unsigned keep;
  asm volatile("s_mov_b32 %0, m0\n\ts_mov_b32 m0, %2\n\ts_nop 0\n\tglobal_load_lds_dwordx4 %1, off\n\ts_mov_b32 m0, %0":"=&s"(keep):"v"(gsrc),"s"(lds_dst):"memory");}
__device__ __forceinline__ float max3f(float a,float b,float c){float r;asm("v_max3_f32 %0, %1, %2, %3":"=v"(r):"v"(a),"v"(b),"v"(c));return r;}
__device__ __forceinline__ float max2f(float a,float b){float r;asm("v_max_f32_e32 %0, %1, %2":"=v"(r):"v"(a),"v"(b));return r;}
__device__ __forceinline__ float fadd_s(float a,float b){float r;asm("v_add_f32_e32 %0, %1, %2":"=v"(r):"v"(a),"v"(b));return r;}
__device__ __forceinline__ float fsub_s(float a,float b){float r;asm("v_sub_f32_e32 %0, %1, %2":"=v"(r):"v"(a),"v"(b));return r;}
typedef float f32x2_t __attribute__((ext_vector_type(2))); typedef __bf16 bf16x2_t __attribute__((ext_vector_type(2)));
__device__ __forceinline__ unsigned cvtpk_s(float lo,float hi){f32x2_t v={lo,hi};bf16x2_t b=__builtin_convertvector(v,bf16x2_t);return __builtin_bit_cast(unsigned,b);}
#define WAIT_BAR(N) asm volatile("s_waitcnt vmcnt(" #N ") lgkmcnt(0)\n\ts_barrier":::"memory")

__device__ __forceinline__ void qkt(f32x16&p0,f32x16&p1,const char*Kslot,const bf16x8*qr,const f32x16&negm,int r32,int hi){
  const char*kb=Kslot+hi*1024+r32*16;
  #pragma unroll
  for(int d0=0;d0<4;++d0){
    const bf16x8 b0=*reinterpret_cast<const bf16x8*>(kb+d0*2048);
    const bf16x8 b1=*reinterpret_cast<const bf16x8*>(kb+d0*2048+512);
    if(d0==0){p0=__builtin_amdgcn_mfma_f32_32x32x16_bf16(b0,qr[0],negm,0,0,0);p1=__builtin_amdgcn_mfma_f32_32x32x16_bf16(b1,qr[0],negm,0,0,0);}
    else{p0=__builtin_amdgcn_mfma_f32_32x32x16_bf16(b0,qr[d0],p0,0,0,0);p1=__builtin_amdgcn_mfma_f32_32x32x16_bf16(b1,qr[d0],p1,0,0,0);}}
}
typedef __attribute__((address_space(3))) const char* lds_cptr;
typedef short v4i16_t __attribute__((ext_vector_type(4)));
__device__ __forceinline__ void kload8(bf16x8*kf,lds_cptr kp){
  kf[0]=*(const __attribute__((address_space(3))) bf16x8*)(kp);      kf[1]=*(const __attribute__((address_space(3))) bf16x8*)(kp+512);
  kf[2]=*(const __attribute__((address_space(3))) bf16x8*)(kp+2048); kf[3]=*(const __attribute__((address_space(3))) bf16x8*)(kp+2560);
  kf[4]=*(const __attribute__((address_space(3))) bf16x8*)(kp+4096); kf[5]=*(const __attribute__((address_space(3))) bf16x8*)(kp+4608);
  kf[6]=*(const __attribute__((address_space(3))) bf16x8*)(kp+6144); kf[7]=*(const __attribute__((address_space(3))) bf16x8*)(kp+6656);
}
__device__ __forceinline__ void kload2(bf16x8*kf,lds_cptr kp,int j){ kf[2*j]=*(const __attribute__((address_space(3))) bf16x8*)(kp+j*2048); kf[2*j+1]=*(const __attribute__((address_space(3))) bf16x8*)(kp+j*2048+512); }
__device__ __forceinline__ s16x4 vtr(lds_cptr p){ return __builtin_bit_cast(s16x4,__builtin_amdgcn_ds_read_tr16_b64_v4i16((__attribute__((address_space(3))) v4i16_t*)p)); }
__device__ __forceinline__ float rowmax(const f32x16&p0,const f32x16&p1){
  float a=max3f(p0[0],p0[1],p1[0]),b=max3f(p0[2],p0[3],p1[1]);a=max3f(a,p1[2],p1[3]);
  #pragma unroll
  for(int r=4;r<16;r+=4){a=max3f(a,p0[r],p0[r+1]);b=max3f(b,p0[r+2],p0[r+3]);a=max3f(a,p1[r],p1[r+1]);b=max3f(b,p1[r+2],p1[r+3]);}
  const float m=max2f(a,b);
  auto rr=__builtin_amdgcn_permlane32_swap(__float_as_uint(m),__float_as_uint(m),false,false);
  return max2f(__uint_as_float(rr[0]),__uint_as_float(rr[1]));
}
__device__ __forceinline__ void pv(f32x16*o,int vb,bf16x8 pa0,bf16x8 pa1,bf16x8 pa2,bf16x8 pa3){
  #pragma unroll
  for(int d0=0;d0<2;++d0){s16x4 lo[4],hi[4];
    #pragma unroll
    for(int ks=0;ks<4;++ks){
      asm volatile("ds_read_b64_tr_b16 %0,%1 offset:%c2":"=&v"(lo[ks]):"v"(vb),"i"(d0*4096+ks*1024):"memory");
      asm volatile("ds_read_b64_tr_b16 %0,%1 offset:%c2":"=&v"(hi[ks]):"v"(vb),"i"(d0*4096+ks*1024+512):"memory");}
    asm volatile("s_waitcnt lgkmcnt(0)":::"memory");SBAR();
    #define PK(k) (bf16x8){lo[k][0],lo[k][1],lo[k][2],lo[k][3],hi[k][0],hi[k][1],hi[k][2],hi[k][3]}
    o[d0]=__builtin_amdgcn_mfma_f32_32x32x16_bf16(pa0,PK(0),o[d0],0,0,0);
    o[d0]=__builtin_amdgcn_mfma_f32_32x32x16_bf16(pa1,PK(1),o[d0],0,0,0);
    o[d0]=__builtin_amdgcn_mfma_f32_32x32x16_bf16(pa2,PK(2),o[d0],0,0,0);
    o[d0]=__builtin_amdgcn_mfma_f32_32x32x16_bf16(pa3,PK(3),o[d0],0,0,0);
    #undef PK
  }
}

#ifndef ATTN_STORE16
#define ATTN_STORE16(p,v) (*(u32x4*)(p)=(v))
#endif
template<int THRL> __device__ __forceinline__ void attn_unit(int qrow0,int h,int NT,const bf16*Q,const bf16*__restrict__ K,const bf16*__restrict__ V,bf16*O,char*shm){
  const int tid=TIDX(),lane=tid&63,r32=lane&31,hi=lane>>5; const int wid=__builtin_amdgcn_readfirstlane(tid>>6);
  const bf16*Qw=Q+(long)(qrow0+wid*QBLK)*QP+h*D;
  const bf16*Kh=K+(h>>2)*D,*Vh=V+(h>>2)*D;
  const unsigned lds0=(unsigned)(uintptr_t)shm;
  float*wsf=(float*)(shm+LDS_WS)+wid*64;
  const bf16*ksrc=Kh+(long)lane*KP+wid*8;
  const bf16*vsrc=Vh+(long)(16*(wid&3)+(lane>>2))*KP+(wid>>2)*32+(lane&3)*8;
  const unsigned kdst=lds0+LDS_K+wid*1024, vdst=lds0+LDS_V+wid*1024;
  #define DMA_K(t,slot) glds16(ksrc+(long)(t)*KVBLK*KP,(unsigned)__builtin_amdgcn_readfirstlane(kdst+(slot)))
  #define DMA_V(t,slot) glds16(vsrc+(long)(t)*KVBLK*KP,(unsigned)__builtin_amdgcn_readfirstlane(vdst+(slot)))
  const int vb0=(int)(lds0+LDS_V)+((lane>>4)&1)*32+(lane&3)*8+(4*hi+((lane&15)>>2))*64;
  const char*Kbase=shm+LDS_K; bf16x8 kf[8];
  const lds_cptr shm3=(lds_cptr)shm; const lds_cptr kp0=shm3+LDS_K+hi*1024+r32*16; const lds_cptr vp0=shm3+LDS_V+((lane>>4)&1)*32+(lane&3)*8+(4*hi+((lane&15)>>2))*64;
  DMA_K(0,0);DMA_V(0,0);DMA_K(1,SLOTB);
  bf16x8 qr[4];
  #pragma unroll
  for(int d0=0;d0<4;++d0)qr[d0]=*reinterpret_cast<const bf16x8*>(&Qw[(long)r32*QP+d0*16+hi*8]);
  float mhat=0.f,l_reg=0.f;f32x16 o[2];o[0]=f32x16{};o[1]=f32x16{};f32x16 negm=f32x16{};asm volatile("":"+v"(negm));
  #define CMASK(P0,P1,t) do{}while(0)
  bool resc=false;
  #define START(P0,P1) do{ const float rm=rowmax(P0,P1); resc=false; \
    { const float dl=rm; mhat=fadd_s(mhat,dl); \
      _Pragma("unroll") for(int r=0;r<16;++r){P0[r]=fsub_s(P0[r],dl);P1[r]=fsub_s(P1[r],dl);} \
      _Pragma("unroll") for(int r=0;r<16;++r)negm[r]=-mhat; asm volatile("":"+v"(negm)); } \
    _Pragma("unroll") for(int r=0;r<16;++r)P0[r]=__builtin_amdgcn_exp2f(P0[r]); }while(0)
  #define RESC() do{ if(resc){ asm volatile("s_waitcnt lgkmcnt(0)":::"memory"); \
      _Pragma("unroll") for(int d_=0;d_<2;++d_) _Pragma("unroll") for(int r=0;r<16;++r)o[d_][r]*=wsf[crow(r,hi)]; } }while(0)
  f32x16 pA0,pA1,pB0,pB1;
  int sl_prev=0,sl_cur=0,sl_next=SLOTB;
  #define ROT() do{sl_prev=sl_cur;sl_cur=sl_next;sl_next=(sl_next==(NSLOT-1)*SLOTB)?0:sl_next+SLOTB;}while(0)
  DMA_K(2,2*SLOTB);
  WAIT_BAR(3);
  qkt(pA0,pA1,Kbase,qr,negm,r32,hi);asm volatile("s_nop 15\n\ts_nop 7":"+v"(pA0),"+v"(pA1));CMASK(pA0,pA1,0);
  START(pA0,pA1);
  _Pragma("unroll") for(int r=0;r<16;++r)pA1[r]=__builtin_amdgcn_exp2f(pA1[r]);
  WAIT_BAR(0);
  DMA_K(3,0);DMA_V(1,SLOTB);
  ROT();
  kload8(kf,kp0+sl_cur);
  WAIT_BAR(2);
  s16x4 vlo[8],vhi[8]; u32x4 pw0,pw1,pw2,pw3;
  #define PKW(P,B) cvtpk_s(P[B],P[B+1])
  #define PAF(k) __builtin_bit_cast(bf16x8,pw##k)
  #define VFR(i) (bf16x8){vlo[i][0],vlo[i][1],vlo[i][2],vlo[i][3],vhi[i][0],vhi[i][1],vhi[i][2],vhi[i][3]}
  #define PIN(x) asm volatile("":"+v"(x))
  #define MX3(a,b,c) __builtin_fmaxf(__builtin_fmaxf((a),(b)),(c))
  #define GAPA(MF,A0,A1,A2,A3,W0,W1,PW) do{ MF; sacc+=A0; sacc+=A1; sacc+=A2; sacc+=A3; PIN(sacc); W0; W1; PIN(PW); SBAR(); }while(0)
  #define EX(v) __builtin_amdgcn_exp2f(v)
  #define GAPB(MF,X,B) do{ MF; X[B]=EX(X[B]); X[B+1]=EX(X[B+1]); X[B+2]=EX(X[B+2]); X[B+3]=EX(X[B+3]); PIN(X); SBAR(); }while(0)
  #define VRD(i) do{ vlo[i]=vtr(vp_+(((i)>>2)*4096+((i)&3)*1024)); vhi[i]=vtr(vp_+(((i)>>2)*4096+((i)&3)*1024+512)); }while(0)
  #define KRD(G,j) do{ if(G){ kload2(kf,kp0+sl_next,j); SBAR(); } }while(0)
  #define STEP(C0,C1,P0,P1,t,GK,GV,GL) do{ SBAR(); \
    const lds_cptr vp_=vp0+sl_prev; \
    VRD(0); SBAR(); float sacc=(P0[0]+P0[1]); \
    GAPA(C0=__builtin_amdgcn_mfma_f32_32x32x16_bf16(kf[0],qr[0],negm,0,0,0), P0[2],P0[3],P0[4],P0[5],     pw0[0]=PKW(P0,0), pw0[1]=PKW(P0,2), pw0); \
    VRD(4); SBAR(); GAPA(C1=__builtin_amdgcn_mfma_f32_32x32x16_bf16(kf[1],qr[0],negm,0,0,0), P0[6],P0[7],P0[8],P0[9],     pw0[2]=PKW(P0,4), pw0[3]=PKW(P0,6), pw0); \
    VRD(1); SBAR(); GAPA(C0=__builtin_amdgcn_mfma_f32_32x32x16_bf16(kf[2],qr[1],C0,0,0,0),   P0[10],P0[11],P0[12],P0[13], pw1[0]=PKW(P0,8), pw1[1]=PKW(P0,10), pw1); \
    VRD(5); SBAR(); GAPA(C1=__builtin_amdgcn_mfma_f32_32x32x16_bf16(kf[3],qr[1],C1,0,0,0),   P0[14],P0[15],P1[0],P1[1],   pw1[2]=PKW(P0,12),pw1[3]=PKW(P0,14), pw1); \
    VRD(2); SBAR(); GAPA(C0=__builtin_amdgcn_mfma_f32_32x32x16_bf16(kf[4],qr[2],C0,0,0,0),   P1[2],P1[3],P1[4],P1[5],     pw2[0]=PKW(P1,0), pw2[1]=PKW(P1,2), pw2); \
    VRD(6); SBAR(); GAPA(C1=__builtin_amdgcn_mfma_f32_32x32x16_bf16(kf[5],qr[2],C1,0,0,0),   P1[6],P1[7],P1[8],P1[9],     pw2[2]=PKW(P1,4), pw2[3]=PKW(P1,6), pw2); \
    VRD(3); SBAR(); GAPA(C0=__builtin_amdgcn_mfma_f32_32x32x16_bf16(kf[6],qr[3],C0,0,0,0),   P1[10],P1[11],P1[12],P1[13], pw3[0]=PKW(P1,8), pw3[1]=PKW(P1,10), pw3); \
    VRD(7); SBAR(); GAPA(C1=__builtin_amdgcn_mfma_f32_32x32x16_bf16(kf[7],qr[3],C1,0,0,0),   P1[14],P1[15],0.f,0.f,       pw3[2]=PKW(P1,12),pw3[3]=PKW(P1,14), pw3); \
    l_reg+=sacc; \
    if(GK){DMA_K((t)+3,sl_cur);} if(GV){DMA_V((t)+1,sl_next);} \
    CMASK(C0,C1,t); \
    { float a=MX3(C0[0],C0[1],C1[0]),b=MX3(C0[2],C0[3],C1[1]); a=MX3(a,C1[2],C1[3]); \
      _Pragma("unroll") for(int r=4;r<16;r+=4){a=MX3(a,C0[r],C0[r+1]);b=MX3(b,C0[r+2],C0[r+3]);a=MX3(a,C1[r],C1[r+1]);b=MX3(b,C1[r+2],C1[r+3]);} \
      float rm=__builtin_fmaxf(a,b); { auto rr=__builtin_amdgcn_permlane32_swap(__float_as_uint(rm),__float_as_uint(rm),false,false); rm=__builtin_fmaxf(__uint_as_float(rr[0]),__uint_as_float(rr[1])); } \
      resc=false; \
      if(__builtin_expect(__any(rm>(float)THRL),0)){ const float dl=__builtin_fmaxf(rm,0.f); mhat+=dl; \
        _Pragma("unroll") for(int r=0;r<16;++r){C0[r]-=dl;C1[r]-=dl;} \
        _Pragma("unroll") for(int r=0;r<16;++r)negm[r]=-mhat; asm volatile("":"+v"(negm)); \
        const float f=__builtin_amdgcn_exp2f(-dl); l_reg*=f; if(hi==0)wsf[r32]=f; resc=true; } } \
    SBAR(); \
    GAPB(o[0]=__builtin_amdgcn_mfma_f32_32x32x16_bf16(PAF(0),VFR(0),o[0],0,0,0), C0,0); \
    GAPB(o[1]=__builtin_amdgcn_mfma_f32_32x32x16_bf16(PAF(0),VFR(4),o[1],0,0,0), C0,4); \
    KRD(GL,0); GAPB(o[0]=__builtin_amdgcn_mfma_f32_32x32x16_bf16(PAF(1),VFR(1),o[0],0,0,0), C0,8); \
    KRD(GL,1); GAPB(o[1]=__builtin_amdgcn_mfma_f32_32x32x16_bf16(PAF(1),VFR(5),o[1],0,0,0), C0,12); \
    KRD(GL,2); GAPB(o[0]=__builtin_amdgcn_mfma_f32_32x32x16_bf16(PAF(2),VFR(2),o[0],0,0,0), C1,0); \
    KRD(GL,3); GAPB(o[1]=__builtin_amdgcn_mfma_f32_32x32x16_bf16(PAF(2),VFR(6),o[1],0,0,0), C1,4); \
    GAPB(o[0]=__builtin_amdgcn_mfma_f32_32x32x16_bf16(PAF(3),VFR(3),o[0],0,0,0), C1,8); \
    GAPB(o[1]=__builtin_amdgcn_mfma_f32_32x32x16_bf16(PAF(3),VFR(7),o[1],0,0,0), C1,12); \
    }while(0)
  int t=1;
  #undef CMASK
  #define CMASK(P0,P1,t) do{}while(0)
  for(;t+5<NT;t+=2){
    STEP(pB0,pB1,pA0,pA1,t,true,true,true);     WAIT_BAR(2); RESC(); ROT();
    STEP(pA0,pA1,pB0,pB1,t+1,true,true,true);   WAIT_BAR(2); RESC(); ROT();
  }
  #undef CMASK
  #define CMASK(P0,P1,t) do{}while(0)
  #define ENDW(tt) do{ if((tt)+3<NT){WAIT_BAR(2);} else if((tt)+2<NT){WAIT_BAR(1);} else {WAIT_BAR(0);} }while(0)
  for(;t+1<NT;t+=2){
    STEP(pB0,pB1,pA0,pA1,t,(t+3<NT),(t+1<NT),(t+1<NT));       ENDW(t);   RESC(); ROT();
    STEP(pA0,pA1,pB0,pB1,t+1,(t+4<NT),(t+2<NT),(t+2<NT));     ENDW(t+1); RESC(); ROT();
  }
  STEP(pB0,pB1,pA0,pA1,NT-1,false,false,false); RESC();
  { float sacc=pB0[0]+pB0[1]; _Pragma("unroll") for(int r=2;r<16;++r)sacc+=pB0[r]; _Pragma("unroll") for(int r=0;r<16;++r)sacc+=pB1[r]; l_reg+=sacc;
    pw0=(u32x4){PKW(pB0,0),PKW(pB0,2),PKW(pB0,4),PKW(pB0,6)};pw1=(u32x4){PKW(pB0,8),PKW(pB0,10),PKW(pB0,12),PKW(pB0,14)};pw2=(u32x4){PKW(pB1,0),PKW(pB1,2),PKW(pB1,4),PKW(pB1,6)};pw3=(u32x4){PKW(pB1,8),PKW(pB1,10),PKW(pB1,12),PKW(pB1,14)};
    SBAR(); pv(o,vb0+sl_cur,PAF(0),PAF(1),PAF(2),PAF(3)); }
  #undef PKW
  #undef PAF
  #undef VFR
  #undef PIN
  #undef MX3
  #undef GAPA
  #undef GAPB
  #undef EX
  #undef VRD
  #undef KRD
  #undef STEP
  #undef ENDW
  {auto rr=__builtin_amdgcn_permlane32_swap(__float_as_uint(l_reg),__float_as_uint(l_reg),false,false);l_reg=__uint_as_float(rr[0])+__uint_as_float(rr[1]);}
  if(hi==0)wsf[32+r32]=l_reg;asm volatile("s_waitcnt lgkmcnt(0)":::"memory");
  float rli[16];
  #pragma unroll
  for(int r=0;r<16;++r)rli[r]=__builtin_amdgcn_rcpf(wsf[32+crow(r,hi)]);
  bf16*Ow=O+(long)(qrow0+wid*QBLK)*QP+h*D;
  { bf16*stg=(bf16*)(shm+LDS_OST)+wid*2048;
    #pragma unroll
    for(int r=0;r<16;++r){const int orow=crow(r,hi);
      #pragma unroll
      for(int d0=0;d0<2;++d0)stg[orow*64+d0*32+r32]=__float2bfloat16(o[d0][r]*rli[r]);}
    asm volatile("s_waitcnt lgkmcnt(0)":::"memory");
    #pragma unroll
    for(int i=0;i<4;++i){const int row=i*8+(lane>>3),ch=lane&7; const u32x4 v=*(const u32x4*)(stg+row*64+ch*8); ATTN_STORE16(Ow+(long)row*QP+ch*8,v);} }
  asm volatile("s_waitcnt lgkmcnt(0)\n\ts_barrier":::"memory");
  #undef DMA_K
  #undef DMA_V
  #undef CMASK
  #undef START
  #undef RESC
  #undef ROT
}
constexpr int ATTN_LDS_BYTES=LDS_BYTES;
#undef SBAR
#undef WAIT_BAR
}
#define LAS __attribute__((address_space(3)))
typedef unsigned short u16;
typedef unsigned U4 __attribute__((ext_vector_type(4)));
typedef unsigned U2 __attribute__((ext_vector_type(2)));
typedef float F4 __attribute__((ext_vector_type(4)));
typedef float F2 __attribute__((ext_vector_type(2)));
typedef short S8 __attribute__((ext_vector_type(8)));
typedef float F16v __attribute__((ext_vector_type(16)));

constexpr int NWAVES = 8, NTHR = 512;
constexpr int L = 16384, CTX = 256, M = L + CTX, D = 1024, FH = 2816;
constexpr float EPS = 1e-6f;
constexpr int LDS_BYTES = 147456;
constexpr size_t MiB = 1u << 20;
constexpr size_t WS_MOD = 64 * 1024, WS_STATS = 512 * 1024;
constexpr size_t SZ_FI = (size_t)5632 * 1024 * 2, SZ_FO = (size_t)1024 * 2816 * 2;
constexpr size_t W_L0 = 1 * MiB, W_FI0 = W_L0, W_FO0 = W_FI0 + SZ_FI, W_GMI = W_FO0 + SZ_FO, W_GMO = W_GMI + (size_t)4096 * 1024 * 2;
constexpr size_t W_L1 = W_GMO + (size_t)1024 * 2048 * 2, W_FI1 = W_L1, W_FO1 = W_FI1 + SZ_FI, W_QKV = W_FO1 + SZ_FO, W_ATO = W_QKV + (size_t)1536 * 1024 * 2;
constexpr size_t W_L2 = W_ATO + (size_t)1024 * 1024 * 2, W_FI2 = W_L2, W_FO2 = W_FI2 + SZ_FI, W_HYI = W_FO2 + SZ_FO, W_HYO = W_HYI + (size_t)3072 * 1024 * 2;
constexpr size_t W_L3 = W_HYO + (size_t)1024 * 1024 * 2, W_FI3 = W_L3, W_FO3 = W_FI3 + SZ_FI, W_SSI = W_FO3 + SZ_FO, W_SSO = W_SSI + (size_t)5376 * 1024 * 2;
constexpr size_t W_END = W_SSO + (size_t)1024 * 2048 * 2;
constexpr size_t WS_YF = 1 * MiB;
static_assert(WS_YF + 64 * MiB <= W_L3, "y_fwd overlay must not touch layer 3 weights");
constexpr size_t WS_X = 107 * MiB; static_assert(W_END <= WS_X, "weights");
constexpr size_t WS_H = 172 * MiB, WS_CB = WS_H, WS_BT = WS_H + (size_t)130 * 4 * 128 * 128 * 2;
constexpr size_t WS_BIG = 205 * MiB;
constexpr size_t B_U = WS_BIG, B_V = WS_BIG + 65 * MiB;
constexpr size_t B_ACT = WS_BIG;
constexpr size_t B_QKVR = WS_BIG, B_Q = WS_BIG + 49 * MiB, B_K = WS_BIG + 82 * MiB, B_VV = WS_BIG + 91 * MiB;
constexpr size_t B_P = WS_BIG, B_KK = WS_BIG, B_YT = WS_BIG + 64 * MiB, B_X0 = WS_BIG + 98 * MiB, B_UT = WS_BIG + 131 * MiB;
constexpr size_t B_Z = WS_BIG, B_XBC = WS_BIG + 65 * MiB, B_DT = WS_BIG + 163 * MiB;
constexpr size_t WS_ACS2 = 65 * MiB, WS_DTV = 70 * MiB;
static_assert(WS_DTV + (size_t)64 * M * 4 <= W_L3 && WS_YF + 64 * MiB <= WS_ACS2, "scan decay tables");
constexpr size_t WS_WV = WS_BIG + 168 * MiB, WS_TOT = WS_WV + 5 * MiB;
constexpr size_t WS_STATSP = WS_BIG + 131 * MiB;
constexpr size_t WS_PART = WS_BIG + 131 * MiB;
constexpr size_t WS_END = WS_BIG + 179 * MiB;
constexpr size_t OUT_KK = 0, OUT_HALO = 8 * MiB;
constexpr size_t WS_HID2 = WS_BIG + 174 * MiB;

typedef float f32x2_t __attribute__((ext_vector_type(2))); typedef __bf16 bf16x2_t __attribute__((ext_vector_type(2)));
__device__ __forceinline__ unsigned pk2(float lo, float hi) { const f32x2_t v = {lo, hi}; const bf16x2_t b = __builtin_convertvector(v, bf16x2_t); return __builtin_bit_cast(unsigned, b); }
__device__ __forceinline__ unsigned f2bf(float f) { return pk2(f, f) & 0xffffu; }
__device__ __forceinline__ float bflo(unsigned w) { return __uint_as_float(w << 16); }
__device__ __forceinline__ float bfhi(unsigned w) { return __uint_as_float(w & 0xffff0000u); }
__device__ __forceinline__ float bf1(u16 h) { return __uint_as_float((unsigned)h << 16); }
__device__ __forceinline__ float wave_sum(float v) {
#pragma unroll
    for (int o = 1; o < 64; o <<= 1) v += __shfl_xor(v, o);
    return v;
}
__device__ __forceinline__ void unpack8(const U4 w, float (&f)[8]) { f[0] = bflo(w.x); f[1] = bfhi(w.x); f[2] = bflo(w.y); f[3] = bfhi(w.y); f[4] = bflo(w.z); f[5] = bfhi(w.z); f[6] = bflo(w.w); f[7] = bfhi(w.w); }
__device__ __forceinline__ U4 pack8(const float (&f)[8]) { U4 w; w.x = pk2(f[0], f[1]); w.y = pk2(f[2], f[3]); w.z = pk2(f[4], f[5]); w.w = pk2(f[6], f[7]); return w; }
__device__ __forceinline__ float softplus_f(float x) { return x > 15.f ? x : log1pf(__expf(x)); }

#define LDS_BAR() asm volatile("s_waitcnt lgkmcnt(0)\n\ts_barrier" ::: "memory")
struct Args { const float* in[40]; float* out; unsigned char* ws; int ph_lo, ph_hi; };
enum { I_X = 0, I_C, I_CTX, I_CCTX, I_N1G, I_N2G, I_MODW, I_MODB, I_FFI, I_FFO, I_FING, I_GMWI, I_GMLG, I_GMLB, I_GMWS, I_GMBS, I_GMWO, I_ATQKV, I_ATQG, I_ATKG, I_ATWO,
       I_HYWI, I_HYCW, I_HYCB, I_HYW1, I_HYB1, I_HYW2, I_HYB2, I_HYW3, I_HYFR, I_HYSK, I_HYWO, I_SSWI, I_SSCW, I_SSCB, I_SSAL, I_SSDB, I_SSDS, I_SSNG, I_SSWO };

__device__ __forceinline__ void p0_transpose_item(const float* W, int K, int N, u16* WT, int mode, float* scr, int item, int lane) {
    const int nblk = N / 32, kb = item / nblk, nb = item % nblk, k0 = 64 * kb, n0 = 32 * nb;
#pragma unroll 8
    for (int i = 0; i < 32; ++i) { const int kk = 2 * i + (lane >> 5); scr[kk * 33 + (lane & 31)] = W[(size_t)(k0 + kk) * N + n0 + (lane & 31)]; }
    __builtin_amdgcn_wave_barrier(); asm volatile("s_waitcnt lgkmcnt(0)" ::: "memory");
    int rbase = n0;
    if (mode == 1) { if (n0 < 2816) rbase = 256 * (n0 >> 7) + (n0 & 127); else { const int n1 = n0 - 2816; rbase = 256 * (n1 >> 7) + 128 + (n1 & 127); } }
    const int c = lane & 7;
#pragma unroll
    for (int j = 0; j < 4; ++j) { const int n = (lane >> 3) + 8 * j; const float* s = scr + (8 * c) * 33 + n;
        U4 o; o.x = pk2(s[0 * 33], s[1 * 33]); o.y = pk2(s[2 * 33], s[3 * 33]); o.z = pk2(s[4 * 33], s[5 * 33]); o.w = pk2(s[6 * 33], s[7 * 33]);
        *(U4*)(WT + (size_t)(rbase + n) * K + k0 + 8 * c) = o; }
    asm volatile("s_waitcnt lgkmcnt(0)" ::: "memory"); __builtin_amdgcn_wave_barrier();
}

__device__ __forceinline__ void convert_layer(const Args& a, int ly, unsigned char* lds, int vb, int nb) {
    const int tid = TIDX(), lane = tid & 63, wave = __builtin_amdgcn_readfirstlane(tid >> 6);
    unsigned char* ws = a.ws;
    float* scr = (float*)(lds + wave * 16384);
    const int gw = vb * NWAVES + wave, NGW = nb * NWAVES;
    constexpr int T_FI = 16 * 176, T_FO = 44 * 32, T_GMI = 16 * 128, T_GMO = 32 * 32, T_QKV = 16 * 48, T_ATO = 16 * 32, T_HYI = 16 * 96, T_HYO = 16 * 32, T_SSI = 16 * 162, T_SSO = 32 * 32;
    const int t_in = ly == 0 ? T_GMI : ly == 1 ? T_QKV : ly == 2 ? T_HYI : T_SSI, t_out = ly == 0 ? T_GMO : ly == 1 ? T_ATO : ly == 2 ? T_HYO : T_SSO;
    const size_t o_fi = ly == 0 ? W_FI0 : ly == 1 ? W_FI1 : ly == 2 ? W_FI2 : W_FI3, o_fo = ly == 0 ? W_FO0 : ly == 1 ? W_FO1 : ly == 2 ? W_FO2 : W_FO3;
    const int nit = T_FI + T_FO + t_in + t_out;
    for (int it = gw; it < nit; it += NGW) {
        int r = it;
        if (r < T_FI) { p0_transpose_item(a.in[I_FFI] + (size_t)ly * 1024 * 5632, 1024, 5632, (u16*)(ws + o_fi), 1, scr, r, lane); continue; } r -= T_FI;
        if (r < T_FO) { p0_transpose_item(a.in[I_FFO] + (size_t)ly * 2816 * 1024, 2816, 1024, (u16*)(ws + o_fo), 0, scr, r, lane); continue; } r -= T_FO;
        if (r < t_in) {
            if (ly == 0) p0_transpose_item(a.in[I_GMWI], 1024, 4096, (u16*)(ws + W_GMI), 0, scr, r, lane);
            else if (ly == 1) p0_transpose_item(a.in[I_ATQKV], 1024, 1536, (u16*)(ws + W_QKV), 0, scr, r, lane);
            else if (ly == 2) p0_transpose_item(a.in[I_HYWI], 1024, 3072, (u16*)(ws + W_HYI), 0, scr, r, lane);
            else p0_transpose_item(a.in[I_SSWI], 1024, 5184, (u16*)(ws + W_SSI), 0, scr, r, lane);
            continue; } r -= t_in;
        if (ly == 0) p0_transpose_item(a.in[I_GMWO], 2048, 1024, (u16*)(ws + W_GMO), 0, scr, r, lane);
        else if (ly == 1) p0_transpose_item(a.in[I_ATWO], 1024, 1024, (u16*)(ws + W_ATO), 0, scr, r, lane);
        else if (ly == 2) p0_transpose_item(a.in[I_HYWO], 1024, 1024, (u16*)(ws + W_HYO), 0, scr, r, lane);
        else p0_transpose_item(a.in[I_SSWO], 2048, 1024, (u16*)(ws + W_SSO), 0, scr, r, lane);
    }
    if (ly == 3) {
        U4* z = (U4*)(ws + W_SSI + (size_t)5184 * 1024 * 2); const U4 zero = {0u, 0u, 0u, 0u};
        for (int i = vb * NTHR + tid; i < 192 * 1024 / 8; i += nb * NTHR) z[i] = zero; }
}

__device__ __forceinline__ void phase_prologue(const Args& a, unsigned char* lds, int bid, int G) {
    const int tid = TIDX(), lane = tid & 63, wave = __builtin_amdgcn_readfirstlane(tid >> 6);
    unsigned char* ws = a.ws;
    float* scr = (float*)(lds + wave * 16384);
    const int gw = bid * NWAVES + wave, NGW = G * NWAVES;
    convert_layer(a, 0, lds, bid, G);
    {
        float* HID2 = (float*)(ws + WS_HID2);
        const float* w1 = a.in[I_HYW1]; const float* w2 = a.in[I_HYW2];
        const float b1 = a.in[I_HYB1][lane], b2 = a.in[I_HYB2][lane], fr = a.in[I_HYFR][lane];
        for (int pos = gw; pos < M; pos += NGW) {
            const int idx = pos < CTX ? pos : pos - CTX; const float Lc = pos < CTX ? 256.f : 16384.f;
            float feat = 0.f;
            if (lane == 0) feat = (float)idx / (Lc - 1.f);
            else if (lane <= 32) { const int b = (lane - 1) & 15; const float f = 1e-4f + (float)b * ((15.f - 1e-4f) / 15.f); const float rev = ((float)idx / Lc) * f;
                feat = lane <= 16 ? __builtin_amdgcn_cosf(rev) : -__builtin_amdgcn_sinf(rev); }
            float acc = b1;
#pragma unroll 11
            for (int e = 0; e < 33; ++e) acc += __shfl(feat, e) * w1[e * 64 + lane];
            const float h1 = __sinf(fr * acc);
            float acc2 = b2;
#pragma unroll 16
            for (int e = 0; e < 64; ++e) acc2 += __shfl(h1, e) * w2[e * 64 + lane];
            HID2[(size_t)pos * 64 + lane] = __sinf(fr * acc2);
        }
    }
    {
        float* MOD = (float*)(ws + WS_MOD); float* red = (float*)lds;
        __syncthreads();
        for (int it = bid; it < 4 * 192; it += G) {
            const int ly = it / 192, cg = it % 192, n = cg * 32 + (lane & 31), kpar = lane >> 5;
            const float* Wm = a.in[I_MODW] + (size_t)ly * 1024 * 6144;
            float a0 = 0.f, a1 = 0.f;
#pragma unroll 8
            for (int k = wave * 128 + kpar; k < wave * 128 + 128; k += 2) { const float w = Wm[(size_t)k * 6144 + n]; a0 += silu_f(a.in[I_C][k]) * w; a1 += silu_f(a.in[I_CCTX][k]) * w; }
            a0 += __shfl_xor(a0, 32); a1 += __shfl_xor(a1, 32);
            if (lane < 32) { red[(wave * 2 + 0) * 32 + lane] = a0; red[(wave * 2 + 1) * 32 + lane] = a1; }
            __syncthreads();
            if (tid < 64) { const int which = tid >> 5, nn = cg * 32 + (tid & 31); float s = a.in[I_MODB][ly * 6144 + nn];
#pragma unroll
                for (int w = 0; w < 8; ++w) s += red[(w * 2 + which) * 32 + (tid & 31)];
                MOD[((size_t)ly * 2 + which) * 6144 + nn] = s; }
            __syncthreads();
        }
    }
}
__device__ __forceinline__ void phase_norm_mod(float* src_ctx, const float* src_lat, float* Xcopy, const float* gain, const float* modL, const float* modC, int sh_off, int sc_off,
                                               u16* H, int row_lo, const float* part, int nks, const float* pgate, int bid, int G) {
    const int lane = TIDX() & 63, wave = __builtin_amdgcn_readfirstlane(TIDX() >> 6);
    const int gw = bid * NWAVES + wave, NGW = G * NWAVES;
#pragma unroll 1
    for (int pass = (row_lo >= CTX ? 1 : 0); pass < 2; ++pass) {
        const float* mod = pass == 0 ? modC : modL;
        F4 ga[4], sh[4];
#pragma unroll
        for (int j = 0; j < 4; ++j) { ga[j] = ((const F4*)gain)[lane + 64 * j] * (((const F4*)(mod + sc_off))[lane + 64 * j] + 1.0f); sh[j] = ((const F4*)(mod + sh_off))[lane + 64 * j]; }
        const int rbeg = pass == 0 ? row_lo : (row_lo > CTX ? row_lo : CTX), rend = pass == 0 ? CTX : M;
        F4 vn[4];
        { const int r0 = rbeg + gw; if (r0 < rend) { const F4* xr = (const F4*)(r0 < CTX ? src_ctx + (size_t)r0 * D : src_lat + (size_t)(r0 - CTX) * D) + lane;
#pragma unroll
            for (int j = 0; j < 4; ++j) vn[j] = xr[64 * j]; } }
        for (int r = rbeg + gw; r < rend; r += NGW) {
            F4 v[4]; float s = 0.f;
#pragma unroll
            for (int j = 0; j < 4; ++j) v[j] = vn[j];
            { const int rn = r + NGW; if (rn < rend) { const F4* xr = (const F4*)(rn < CTX ? src_ctx + (size_t)rn * D : src_lat + (size_t)(rn - CTX) * D) + lane;
#pragma unroll
                for (int j = 0; j < 4; ++j) vn[j] = xr[64 * j]; } }
            if (part && r < CTX) {
#pragma unroll
                for (int j = 0; j < 4; ++j) { F4 ps = {0.f, 0.f, 0.f, 0.f}; for (int kz = 0; kz < nks; ++kz) ps += ((const F4*)(part + ((size_t)kz * 256 + r) * D))[lane + 64 * j];
                    v[j] += ((const F4*)pgate)[lane + 64 * j] * ps; ((F4*)(src_ctx + (size_t)r * D))[lane + 64 * j] = v[j]; }
            }
#pragma unroll
            for (int j = 0; j < 4; ++j) s += (v[j].x * v[j].x + v[j].y * v[j].y) + (v[j].z * v[j].z + v[j].w * v[j].w);
            const float rstd = rsqrtf(wave_sum(s) * (1.f / D) + EPS);
            if (Xcopy) { F4* xc = (F4*)(Xcopy + (size_t)r * D) + lane;
#pragma unroll
                for (int j = 0; j < 4; ++j) xc[64 * j] = v[j]; }
            U2* o8 = (U2*)(H + (size_t)r * D) + lane;
#pragma unroll
            for (int j = 0; j < 4; ++j) { const F4 y = v[j] * rstd * ga[j] + sh[j]; U2 w; w.x = pk2(y.x, y.y); w.y = pk2(y.z, y.w); o8[64 * j] = w; }
        }
    }
}
__device__ __forceinline__ void phase_ln_stats(const u16* V, float* STATS, int bid, int G) {
    const int lane = TIDX() & 63, wave = __builtin_amdgcn_readfirstlane(TIDX() >> 6);
    const int gw = bid * NWAVES + wave, NGW = G * NWAVES;
    for (int r = gw; r < M; r += NGW) {
        const U4* vr = (const U4*)(V + (size_t)r * 2048) + lane;
        float f[4][8]; float s = 0.f;
#pragma unroll
        for (int j = 0; j < 4; ++j) { unpack8(vr[64 * j], f[j]);
#pragma unroll
            for (int e = 0; e < 8; ++e) s += f[j][e]; }
        const float mean = wave_sum(s) * (1.f / 2048.f); float q = 0.f;
#pragma unroll
        for (int j = 0; j < 4; ++j)
#pragma unroll
            for (int e = 0; e < 8; ++e) { const float d = f[j][e] - mean; q += d * d; }
        const float rstd = rsqrtf(wave_sum(q) * (1.f / 2048.f) + EPS);
        if (lane == 0) { STATS[2 * r] = mean; STATS[2 * r + 1] = rstd; }
    }
}
__device__ __forceinline__ void phase_qk_rope(const u16* QKVR, const float* q_g, const float* k_g, u16* Qb, u16* Kb, u16* Vb, int bid, int G) {
    const int lane = TIDX() & 63, wave = __builtin_amdgcn_readfirstlane(TIDX() >> 6), l16 = lane & 15, hq = lane >> 4;
    const int gw = bid * NWAVES + wave, NGW = G * NWAVES;
    const int e0 = 4 * l16, i0 = e0 & 31;
    const F4 qg = *(const F4*)(q_g + e0), kg = *(const F4*)(k_g + e0);
    float inv[4];
#pragma unroll
    for (int j = 0; j < 4; ++j) inv[j] = exp2f(-(float)((i0 + j) & 15) * (13.287712379549449f / 16.f));
    constexpr float C2 = 0.125f * 1.4426950408889634f;
    for (int r = gw; r < M; r += NGW) {
        float cs[4] = {1.f, 1.f, 1.f, 1.f}, sn[4] = {0.f, 0.f, 0.f, 0.f};
        if (r >= CTX) { const int t = r - CTX; const float pos = i0 < 16 ? (float)(t >> 6) : (float)(t & 63);
#pragma unroll
            for (int j = 0; j < 4; ++j) { const float a = pos * inv[j]; cs[j] = __cosf(a); sn[j] = __sinf(a); } }
        const U2* row = (const U2*)(QKVR + (size_t)r * 1536);
#pragma unroll
        for (int i = 0; i < 6; ++i) {
            const U2 w = row[64 * i + lane]; const int hd = 4 * i + hq;
            if (i == 5) { ((U2*)(Vb + (size_t)r * 256))[(hd - 20) * 16 + l16] = w; continue; }
            float v[4] = {bflo(w.x), bfhi(w.x), bflo(w.y), bfhi(w.y)};
            float ss = (v[0] * v[0] + v[1] * v[1]) + (v[2] * v[2] + v[3] * v[3]);
#pragma unroll
            for (int o = 1; o < 16; o <<= 1) ss += __shfl_xor(ss, o);
            const float rs = rsqrtf(ss * (1.f / 64.f) + EPS);
            const bool isq = i < 4; const F4 gn = isq ? qg : kg;
            float y[4], p[4];
#pragma unroll
            for (int j = 0; j < 4; ++j) y[j] = v[j] * rs * gn[j];
#pragma unroll
            for (int j = 0; j < 4; ++j) p[j] = __shfl_xor(y[j], 8);
#pragma unroll
            for (int j = 0; j < 4; ++j) y[j] = l16 < 8 ? y[j] * cs[j] - p[j] * sn[j] : y[j] * cs[j] + p[j] * sn[j];
            U2 o2;
            if (isq) { o2.x = pk2(y[0] * C2, y[1] * C2); o2.y = pk2(y[2] * C2, y[3] * C2); ((U2*)(Qb + (size_t)r * 1024))[hd * 16 + l16] = o2; }
            else { o2.x = pk2(y[0], y[1]); o2.y = pk2(y[2], y[3]); ((U2*)(Kb + (size_t)r * 256))[(hd - 16) * 16 + l16] = o2; }
        }
    }
}
__device__ __forceinline__ void phase_ssd_finish(const u16* YF, const u16* YB, const u16* XBC, u16* Z, const float* d_skip, const float* norm_g, int bid, int G) {
    const int lane = TIDX() & 63, wave = __builtin_amdgcn_readfirstlane(TIDX() >> 6);
    const int gw = bid * NWAVES + wave, NGW = G * NWAVES;
    for (int t = gw; t < L; t += NGW) {
        const size_t R = (size_t)t + CTX;
#pragma unroll
        for (int j = 0; j < 4; ++j) {
            const int ch = 512 * j + 8 * lane;
            float yf[8], yb[8], xs[8], z[8], o[8];
            unpack8(*(const U4*)(YF + (size_t)t * 2048 + ch), yf); unpack8(*(const U4*)(YB + (size_t)t * 2048 + ch), yb);
            unpack8(*(const U4*)(XBC + R * 3072 + ch), xs); unpack8(*(const U4*)(Z + R * 2048 + ch), z);
            const float ds = d_skip[ch >> 6]; float ss = 0.f;
#pragma unroll
            for (int e = 0; e < 8; ++e) { const float y = yf[e] + yb[e] + xs[e] * ds; o[e] = y * silu_f(z[e]); ss += o[e] * o[e]; }
            const float rs = rsqrtf(wave_sum(ss) * (1.f / 512.f) + EPS);
            const F4 g0 = *(const F4*)(norm_g + ch), g1 = *(const F4*)(norm_g + ch + 4);
            o[0] *= rs * g0.x; o[1] *= rs * g0.y; o[2] *= rs * g0.z; o[3] *= rs * g0.w; o[4] *= rs * g1.x; o[5] *= rs * g1.y; o[6] *= rs * g1.z; o[7] *= rs * g1.w;
            *(U4*)(Z + R * 2048 + ch) = pack8(o);
        }
    }
}
__device__ __forceinline__ void phase_final(const float* X, const float* gain, float* out, int bid, int G) {
    const int lane = TIDX() & 63, wave = __builtin_amdgcn_readfirstlane(TIDX() >> 6);
    const int gw = bid * NWAVES + wave, NGW = G * NWAVES;
    F4 gn[4];
#pragma unroll
    for (int j = 0; j < 4; ++j) gn[j] = ((const F4*)gain)[lane + 64 * j];
    F4 vn[4];
    if (gw < L) { const F4* xr = (const F4*)(X + (size_t)(gw + CTX) * D) + lane;
#pragma unroll
        for (int j = 0; j < 4; ++j) vn[j] = xr[64 * j]; }
    for (int t = gw; t < L; t += NGW) {
        F4 v[4]; float s = 0.f;
#pragma unroll
        for (int j = 0; j < 4; ++j) { v[j] = vn[j]; s += (v[j].x * v[j].x + v[j].y * v[j].y) + (v[j].z * v[j].z + v[j].w * v[j].w); }
        if (t + NGW < L) { const F4* xr = (const F4*)(X + (size_t)(t + NGW + CTX) * D) + lane;
#pragma unroll
            for (int j = 0; j < 4; ++j) vn[j] = xr[64 * j]; }
        const float rstd = rsqrtf(wave_sum(s) * (1.f / D) + EPS);
        F4* o = (F4*)(out + (size_t)t * D) + lane;
#pragma unroll
        for (int j = 0; j < 4; ++j) o[64 * j] = v[j] * rstd * gn[j];
    }
}
__device__ __forceinline__ void phase_spatial(u16* U, const u16* V, const float* STATS, const float* gws, const float* gbs, const float* lng, const float* lnb, unsigned char* lds, int bid, int G) {
    const int tid = TIDX(), lane = tid & 63, wave = __builtin_amdgcn_readfirstlane(tid >> 6), il = lane & 15, quad = lane >> 4;
    u16* wsL = (u16*)lds;
    u16* vnT = (u16*)(lds + 128 * 136 * 2);
    float* rst = (float*)(lds + 128 * 136 * 2 + 256 * 136 * 2);
    for (int it = bid; it < 130 * 8; it += G) {
        const int n = it >> 3, g = it & 7;
        __syncthreads();
        if (tid < 128) { const F4* sp = (const F4*)(STATS + ((size_t)n * 128 + tid) * 64); float s1 = 0.f, s2 = 0.f;
#pragma unroll
            for (int i = 0; i < 16; ++i) { const F4 v = sp[i]; s1 += v.x + v.z; s2 += v.y + v.w; }
            const float mean = s1 * (1.f / 2048.f); rst[2 * tid] = mean; rst[2 * tid + 1] = rsqrtf(fmaxf(s2 * (1.f / 2048.f) - mean * mean, 0.f) + EPS); }
        __syncthreads();
#pragma unroll
        for (int i = 0; i < 8; ++i) { const int piece = tid + NTHR * i, p = piece >> 5, q4 = (piece & 31) * 4;
            const F4 w = *(const F4*)(gws + ((size_t)g * 128 + p) * 128 + q4); U2 o; o.x = pk2(w.x, w.y); o.y = pk2(w.z, w.w); *(U2*)(wsL + p * 136 + q4) = o; }
#pragma unroll
        for (int i = 0; i < 4; ++i) { const int cc = wave + 8 * i, l2 = lane;
            const size_t row = (size_t)n * 128 + 2 * l2; const int c0 = g * 256 + cc * 8;
            float f0[8], f1[8]; unpack8(*(const U4*)(V + row * 2048 + c0), f0); unpack8(*(const U4*)(V + (row + 1) * 2048 + c0), f1);
            const float m0 = rst[4 * l2], r0 = rst[4 * l2 + 1], m1 = rst[4 * l2 + 2], r1 = rst[4 * l2 + 3];
            const F4 ga = *(const F4*)(lng + c0), gb = *(const F4*)(lng + c0 + 4), ba = *(const F4*)(lnb + c0), bb = *(const F4*)(lnb + c0 + 4);
            const float gg[8] = {ga.x, ga.y, ga.z, ga.w, gb.x, gb.y, gb.z, gb.w}, bbv[8] = {ba.x, ba.y, ba.z, ba.w, bb.x, bb.y, bb.z, bb.w};
            unsigned* vt = (unsigned*)vnT + (cc * 8) * 68 + l2;
#pragma unroll
            for (int e = 0; e < 8; ++e) vt[e * 68] = pk2((f0[e] - m0) * r0 * gg[e] + bbv[e], (f1[e] - m1) * r1 * gg[e] + bbv[e]); }
        __syncthreads();
        F4 acc[8][2];
#pragma unroll
        for (int mt = 0; mt < 8; ++mt) { acc[mt][0] = (F4){0.f, 0.f, 0.f, 0.f}; acc[mt][1] = (F4){0.f, 0.f, 0.f, 0.f}; }
#pragma unroll
        for (int ks = 0; ks < 4; ++ks) {
            S8 vf[2], wf[8];
#pragma unroll
            for (int nt = 0; nt < 2; ++nt) vf[nt] = *(const S8*)(vnT + (32 * wave + 16 * nt + il) * 136 + 32 * ks + 8 * quad);
#pragma unroll
            for (int mt = 0; mt < 8; ++mt) wf[mt] = *(const S8*)(wsL + (16 * mt + il) * 136 + 32 * ks + 8 * quad);
#pragma unroll
            for (int mt = 0; mt < 8; ++mt)
#pragma unroll
                for (int nt = 0; nt < 2; ++nt) acc[mt][nt] = __builtin_amdgcn_mfma_f32_16x16x32_bf16(vf[nt], wf[mt], acc[mt][nt], 0, 0, 0);
        }
#pragma unroll
        for (int mt = 0; mt < 8; ++mt) { const int p = 16 * mt + il; const float b = gbs[g * 128 + p];
#pragma unroll
            for (int nt = 0; nt < 2; ++nt) { U2* up = (U2*)(U + ((size_t)n * 128 + p) * 2048 + g * 256 + 32 * wave + 16 * nt + 4 * quad); const U2 uu = *up;
                U2 o; o.x = pk2(bflo(uu.x) * (acc[mt][nt][0] + b), bfhi(uu.x) * (acc[mt][nt][1] + b)); o.y = pk2(bflo(uu.y) * (acc[mt][nt][2] + b), bfhi(uu.y) * (acc[mt][nt][3] + b)); *up = o; } }
    }
}
__device__ __forceinline__ void phase_attention(const u16* Qb, const u16* Kb, const u16* Vb, u16* Ob, unsigned char* lds, int bid, int G) {
    using namespace attn_body;
    for (int u = bid; u < 1024 + 16; u += G) {
        int qrow0, h, NT;
        if (u < 1024) { h = u >> 6; qrow0 = CTX + (u & 63) * 256; NT = M / 64; } else { h = u - 1024; qrow0 = 0; NT = CTX / 64; }
        attn_unit<8>(qrow0, h, NT, (const bf16*)Qb, (const bf16*)Kb, (const bf16*)Vb, (bf16*)Ob, (char*)lds);
    }
}
__device__ __forceinline__ void phase_hy_dwconv(const u16* P, const float* cw, const float* cb, u16* X0, u16* UT, unsigned char* lds, int bid, int G) {
    const int tid = TIDX(); u16* uL = (u16*)lds;
    const int cc = tid & 7, rg = tid >> 3;
    for (int it = bid; it < 65 * 16; it += G) {
        const int rt = it >> 4, ct = it & 15;
        __syncthreads();
        float uo[4][8];
#pragma unroll
        for (int grp = 0; grp < 3; ++grp) {
            const int col = grp * 1024 + ct * 64 + cc * 8;
            float w0[8], w1[8], w2[8], bb[8];
#pragma unroll
            for (int h2 = 0; h2 < 2; ++h2) { const F4 a = *(const F4*)(cw + col + 4 * h2), b = *(const F4*)(cw + 3072 + col + 4 * h2), c = *(const F4*)(cw + 6144 + col + 4 * h2), d = *(const F4*)(cb + col + 4 * h2);
#pragma unroll
                for (int e = 0; e < 4; ++e) { w0[4 * h2 + e] = a[e]; w1[4 * h2 + e] = b[e]; w2[4 * h2 + e] = c[e]; bb[4 * h2 + e] = d[e]; } }
            const int Rb = rt * 256 + rg * 4;
            const U4 zero = {0u, 0u, 0u, 0u};
            float pv[8], cv[8], nv[8];
            unpack8((Rb != 0 && Rb != CTX) ? *(const U4*)(P + (size_t)(Rb - 1) * 3072 + col) : zero, pv);
            unpack8(*(const U4*)(P + (size_t)Rb * 3072 + col), cv);
#pragma unroll
            for (int r = 0; r < 4; ++r) {
                const int R = Rb + r;
                unpack8((R != CTX - 1 && R != M - 1) ? *(const U4*)(P + (size_t)(R + 1) * 3072 + col) : zero, nv);
                float val[8];
#pragma unroll
                for (int e = 0; e < 8; ++e) { val[e] = pv[e] * w0[e] + cv[e] * w1[e] + nv[e] * w2[e] + bb[e]; pv[e] = cv[e]; cv[e] = nv[e]; }
                if (grp == 0) *(U4*)(X0 + (size_t)R * 1024 + ct * 64 + cc * 8) = pack8(val);
                else if (grp == 1) {
#pragma unroll
                    for (int e = 0; e < 8; ++e) uo[r][e] = val[e];
                } else {
#pragma unroll
                    for (int e = 0; e < 8; ++e) uo[r][e] *= val[e];
                }
            }
        }
#pragma unroll
        for (int e = 0; e < 8; ++e) { U2 o; o.x = pk2(uo[0][e], uo[1][e]); o.y = pk2(uo[2][e], uo[3][e]); *(U2*)(uL + (cc * 8 + e) * 264 + rg * 4) = o; }
        __syncthreads();
        { const int ch = tid >> 3, piece = tid & 7;
#pragma unroll
          for (int k2 = 0; k2 < 4; ++k2) { const int off = (piece + 8 * k2) * 8; *(U4*)(UT + (size_t)(ct * 64 + ch) * M + rt * 256 + off) = *(const U4*)(uL + ch * 264 + off); } }
    }
}
__device__ __forceinline__ float hy_delta(int d) { return 3.0701134573253946f + (float)d * ((15.350567286626973f - 3.0701134573253946f) / 1023.f); }
__device__ __forceinline__ void phase_hy_ktgen(const float* HID2, const float* w3, const float* skip, u16* KK, unsigned char* lds, int bid, int G) {
    const int tid = TIDX(), t = tid & 63, dg = __builtin_amdgcn_readfirstlane(tid >> 6);
    float* hs = (float*)lds; float* wf = hs + 64 * 65; float* wb = wf + 64 * 64;
    if (bid < 12) return;
    for (int it = bid - 12; it < 256 * 16; it += G - 12) {
        const int tt = it >> 4, dt = it & 15;
        __syncthreads();
#pragma unroll
        for (int i = 0; i < 8; ++i) { const int id = tid + NTHR * i, a = id >> 6, e = id & 63;
            hs[a * 65 + e] = HID2[(size_t)(CTX + 64 * tt + a) * 64 + e];
            wf[a * 64 + e] = w3[(size_t)a * 2048 + 64 * dt + e]; wb[a * 64 + e] = w3[(size_t)a * 2048 + 1024 + 64 * dt + e]; }
        __syncthreads();
        float af[8], ab[8];
#pragma unroll
        for (int q = 0; q < 8; ++q) { af[q] = 0.f; ab[q] = 0.f; }
#pragma unroll 4
        for (int e = 0; e < 64; ++e) { const float h = hs[t * 65 + e];
            const F4 f0 = *(const F4*)(wf + e * 64 + 8 * dg), f1 = *(const F4*)(wf + e * 64 + 8 * dg + 4), b0 = *(const F4*)(wb + e * 64 + 8 * dg), b1 = *(const F4*)(wb + e * 64 + 8 * dg + 4);
            af[0] += h * f0.x; af[1] += h * f0.y; af[2] += h * f0.z; af[3] += h * f0.w; af[4] += h * f1.x; af[5] += h * f1.y; af[6] += h * f1.z; af[7] += h * f1.w;
            ab[0] += h * b0.x; ab[1] += h * b0.y; ab[2] += h * b0.z; ab[3] += h * b0.w; ab[4] += h * b1.x; ab[5] += h * b1.y; ab[6] += h * b1.z; ab[7] += h * b1.w; }
        const int tpos = 64 * tt + t; const float tn = (float)tpos / 16383.f;
#pragma unroll
        for (int q = 0; q < 8; ++q) { const int d = 64 * dt + 8 * dg + q; const float dec = __expf(-tn * hy_delta(d));
            float vf = af[q] * dec; if (tpos == 0) vf += skip[d];
            KK[(size_t)d * 32768 + 16384 + tpos] = (u16)f2bf(vf);
            if (tpos == 0) KK[(size_t)d * 32768] = 0; else KK[(size_t)d * 32768 + 16384 - tpos] = (u16)f2bf(ab[q] * dec); }
    }
}
__device__ __forceinline__ int ur_phys(int g) { return (g & ~15) | ((g ^ (g >> 4)) & 15); }
__device__ __forceinline__ void conv_build_load(const unsigned* kk32, int k0, int wave, int lane, unsigned (&v)[18]) {
#pragma unroll
    for (int i = 0; i < 18; ++i) { const int idx = 8 * k0 + lane + 64 * i + (wave >> 1); v[i] = (idx < 16384 && i < 17) ? kk32[idx] : 0u; }
}
__device__ __forceinline__ void conv_build_store(unsigned* sh, int wave, int lane, const unsigned (&v)[18]) {
#pragma unroll
    for (int i = 0; i < 17; ++i) { const int w = lane + 64 * i; unsigned o = v[i];
        if (wave & 1) { unsigned nx = __shfl_down(v[i], 1); const unsigned n0 = __shfl(v[i + 1], 0); if (lane == 63) nx = n0; o = (v[i] >> 16) | (nx << 16); }
        if (w < 1064) sh[w] = o; }
}
__device__ __forceinline__ void phase_hy_conv(const u16* KK, const u16* UT, u16* YT, const float* HID2, const float* w3, const float* skip, unsigned char* lds, int bid, int G) {
    const int tid = TIDX(), lane = tid & 63, wave = __builtin_amdgcn_readfirstlane(tid >> 6), n32 = lane & 31, hi = lane >> 5;
    constexpr int UR_B = 0, UR_N = 20480, SH_B = UR_N * 2, SHB = 4416, SHBUF = 8 * SHB;
    u16* UR = (u16*)(lds + UR_B);
    for (int it = bid; it < 2048; it += G) {
        __syncthreads();
        if (it < 1024) {
            const int d = it;
            const unsigned* kk32 = (const unsigned*)(KK + (size_t)d * 32768);
            unsigned pv[18];
            conv_build_load(kk32, 0, wave, lane, pv);
            { U4* ur = (U4*)UR; const U4 zero = {0u, 0u, 0u, 0u}; for (int i = tid; i < UR_N / 8; i += NTHR) ur[i] = zero; }
            __syncthreads();
#pragma unroll
            for (int i = 0; i < 4; ++i) { const int s0 = (tid + NTHR * i) * 8; float f[8]; unpack8(*(const U4*)(UT + (size_t)d * M + CTX + s0), f);
#pragma unroll
                for (int e = 0; e < 8; ++e) { const int y = L + 2048 - (s0 + e); UR[(ur_phys(y >> 3) << 3) | (y & 7)] = (u16)f2bf(f[e]); } }
            conv_build_store((unsigned*)(lds + SH_B + wave * SHB), wave, lane, pv);
            __syncthreads();
            F16v acc0, acc1;
#pragma unroll
            for (int r = 0; r < 16; ++r) { acc0[r] = 0.f; acc1[r] = 0.f; }
            const int I = wave, ii = 32 * I + n32;
            const int gb = hi - 8 * ii + 256;
            const int aoff = SH_B + (n32 & 7) * SHB + ((n32 >> 3) * 8 + 8 * hi) * 2;
            for (int c = 0; c < 16; ++c) {
                const int k0 = 128 * c;
                if (c + 1 < 16) conv_build_load(kk32, k0 + 128, wave, lane, pv);
                if (c >= I && c <= I + 8) {
                    const unsigned char* ab = lds + aoff + (c & 1) * SHBUF;
#define CONV_A(kk) (*(const S8*)(ab + 32 * (kk)))
#define CONV_B(kk) (*(const S8*)(UR + (ur_phys(gb + 2 * (k0 + (kk))) << 3)))
#define CONV_MM(a_lo, a_hi, b) do { acc0 = __builtin_amdgcn_mfma_f32_32x32x16_bf16(a_lo, b, acc0, 0, 0, 0); acc1 = __builtin_amdgcn_mfma_f32_32x32x16_bf16(a_hi, b, acc1, 0, 0, 0); } while (0)
                    S8 ar[8], br[8];
#pragma unroll
                    for (int x = 0; x < 6; ++x) ar[x] = CONV_A(x);
#pragma unroll
                    for (int x = 0; x < 4; ++x) br[x] = CONV_B(x);
                    for (int k = 0; k < 128; k += 8) {
#pragma unroll
                        for (int j = 0; j < 8; ++j) {
                            ar[(6 + j) & 7] = CONV_A(k + 6 + j); br[(4 + j) & 7] = CONV_B(k + 4 + j);
                            __builtin_amdgcn_sched_barrier(0);
                            CONV_MM(ar[j & 7], ar[(j + 2) & 7], br[j & 7]);
                            __builtin_amdgcn_sched_barrier(0);
                        }
                    }
#undef CONV_A
#undef CONV_B
#undef CONV_MM
                }
                if (c + 1 < 16) conv_build_store((unsigned*)(lds + SH_B + ((c + 1) & 1) * SHBUF + wave * SHB), wave, lane, pv);
                __syncthreads();
            }
#pragma unroll
            for (int rg = 0; rg < 4; ++rg) { const int a0 = 8 * rg + 4 * hi;
                U2 o0; o0.x = pk2(acc0[4 * rg], acc0[4 * rg + 1]); o0.y = pk2(acc0[4 * rg + 2], acc0[4 * rg + 3]);
                U2 o1; o1.x = pk2(acc1[4 * rg], acc1[4 * rg + 1]); o1.y = pk2(acc1[4 * rg + 2], acc1[4 * rg + 3]);
                *(U2*)(YT + (size_t)d * M + CTX + 64 * ii + a0) = o0; *(U2*)(YT + (size_t)d * M + CTX + 64 * ii + 32 + a0) = o1; }
        } else {
            const int d = it - 1024; float* kkc = (float*)lds; float* uc = kkc + 512;
            if (tid < 511) { const int lag = tid - 255, m = lag < 0 ? -lag : lag; const float* hrow = HID2 + (size_t)m * 64; const float* wcol = w3 + (lag < 0 ? 1024 : 0) + d; float acc = 0.f;
#pragma unroll 8
                for (int e = 0; e < 64; ++e) acc += hrow[e] * wcol[(size_t)e * 2048];
                float v = acc * __expf(-((float)m / 255.f) * hy_delta(d)); if (lag == 0) v += skip[d]; kkc[tid] = v; }
            if (tid < 256) uc[tid] = bf1(UT[(size_t)d * M + tid]);
            __syncthreads();
            if (tid < 256) { float y = 0.f;
#pragma unroll 8
                for (int s = 0; s < 256; ++s) y += kkc[tid - s + 255] * uc[s];
                YT[(size_t)d * M + tid] = (u16)f2bf(y); }
        }
    }
}
__device__ __forceinline__ void phase_hy_tgate(u16* X0, const u16* YT, unsigned char* lds, int bid, int G) {
    const int tid = TIDX(); u16* yL = (u16*)lds;
    for (int it = bid; it < 65 * 16; it += G) {
        const int rt = it >> 4, ct = it & 15;
        __syncthreads();
        { const int ch = tid >> 3, piece = tid & 7;
#pragma unroll
          for (int k2 = 0; k2 < 4; ++k2) { const int off = (piece + 8 * k2) * 8; *(U4*)(yL + ch * 264 + off) = *(const U4*)(YT + (size_t)(ct * 64 + ch) * M + rt * 256 + off); } }
        __syncthreads();
        const int cc = tid & 7, rg = tid >> 3;
        float yv[4][8];
#pragma unroll
        for (int e = 0; e < 8; ++e) { const U2 w = *(const U2*)(yL + (cc * 8 + e) * 264 + rg * 4); yv[0][e] = bflo(w.x); yv[1][e] = bfhi(w.x); yv[2][e] = bflo(w.y); yv[3][e] = bfhi(w.y); }
#pragma unroll
        for (int r = 0; r < 4; ++r) { U4* xp = (U4*)(X0 + (size_t)(rt * 256 + rg * 4 + r) * 1024 + ct * 64 + cc * 8); float f[8]; unpack8(*xp, f);
#pragma unroll
            for (int e = 0; e < 8; ++e) f[e] *= yv[r][e];
            *xp = pack8(f); }
    }
}
__device__ __forceinline__ void phase_ssd_conv(u16* XBC, const u16* HALO, const float* cw, const float* cb, int bid, int G) {
    const int lane = TIDX() & 63, wave = __builtin_amdgcn_readfirstlane(TIDX() >> 6);
    const int gw = bid * NWAVES + wave, NGW = G * NWAVES;
    const U4 zero = {0u, 0u, 0u, 0u};
    for (int it = gw; it < (M / 32) * 6; it += NGW) {
        const int seg = it / 6, col = (it % 6) * 512 + 8 * lane;
        float w0[8], w1[8], w2[8], bb[8];
#pragma unroll
        for (int h2 = 0; h2 < 2; ++h2) { const F4 a = *(const F4*)(cw + col + 4 * h2), b = *(const F4*)(cw + 3072 + col + 4 * h2), c = *(const F4*)(cw + 6144 + col + 4 * h2), d = *(const F4*)(cb + col + 4 * h2);
#pragma unroll
            for (int e = 0; e < 4; ++e) { w0[4 * h2 + e] = a[e]; w1[4 * h2 + e] = b[e]; w2[4 * h2 + e] = c[e]; bb[4 * h2 + e] = d[e]; } }
        u16* base = XBC + (size_t)(seg * 32) * 3072 + col;
        U4 prevw = (seg == 0 || seg == CTX / 32) ? zero : *(const U4*)(HALO + ((size_t)(seg - 1) * 2 + 1) * 3072 + col);
        const U4 nextw = (seg == CTX / 32 - 1 || seg == M / 32 - 1) ? zero : *(const U4*)(HALO + ((size_t)(seg + 1) * 2) * 3072 + col);
#pragma unroll
        for (int half = 0; half < 2; ++half) {
            U4 rw[17];
#pragma unroll
            for (int r = 0; r < 17; ++r) { const int rr = 16 * half + r; rw[r] = rr < 32 ? *(const U4*)(base + (size_t)rr * 3072) : nextw; }
            float pv[8], cv[8], nv[8];
            unpack8(prevw, pv); unpack8(rw[0], cv);
#pragma unroll
            for (int r = 0; r < 16; ++r) {
                unpack8(rw[r + 1], nv);
                float o[8];
#pragma unroll
                for (int e = 0; e < 8; ++e) { o[e] = silu_f(pv[e] * w0[e] + cv[e] * w1[e] + nv[e] * w2[e] + bb[e]); pv[e] = cv[e]; cv[e] = nv[e]; }
                *(U4*)(base + (size_t)(16 * half + r) * 3072) = pack8(o);
            }
            prevw = rw[15];
        }
    }
}
__device__ __forceinline__ void phase_ssd_cb(const u16* XBC, u16* CB, u16* BT, const float* DT, const float* a_log, const float* dt_bias, float* ACS2, float* DTV, float* WV, float* TOT, unsigned char* lds, int bid, int G) {
    const int tid = TIDX(), lane = tid & 63, wave = __builtin_amdgcn_readfirstlane(tid >> 6), il = lane & 15, quad = lane >> 4;
    unsigned* T = (unsigned*)lds;
    for (int it = bid; it < 130 * 4; it += G) {
        const int c = it >> 2, g = it & 3;
        const int i = 16 * wave + il;
        __syncthreads();
#pragma unroll
        for (int q = 0; q < 2; ++q) { const int nc = 2 * wave + q;
            const U4 r0 = *(const U4*)(XBC + (size_t)(128 * c + 2 * lane) * 3072 + 2048 + 128 * g + 8 * nc), r1 = *(const U4*)(XBC + (size_t)(128 * c + 2 * lane + 1) * 3072 + 2048 + 128 * g + 8 * nc);
            const unsigned a[4] = {r0.x, r0.y, r0.z, r0.w}, b[4] = {r1.x, r1.y, r1.z, r1.w};
#pragma unroll
            for (int e2 = 0; e2 < 4; ++e2) { T[(8 * nc + 2 * e2) * 68 + lane] = (a[e2] & 0xffffu) | (b[e2] << 16); T[(8 * nc + 2 * e2 + 1) * 68 + lane] = (a[e2] >> 16) | (b[e2] & 0xffff0000u); } }
#pragma unroll
        for (int q2 = 0; q2 < 2; ++q2) { const int pr = 2 * wave + q2, dir = pr >> 3, h = 8 * g + (pr & 7), dh = dir * 32 + h;
            const float Ah = -__expf(a_log[dh]), dtb = dt_bias[dh];
            const size_t R0 = (size_t)c * 128;
            const float d0 = softplus_f(DT[(R0 + 2 * lane) * 64 + dh] + dtb), d1 = softplus_f(DT[(R0 + 2 * lane + 1) * 64 + dh] + dtb);
            const float a0 = d0 * Ah * 1.4426950408889634f, a1 = d1 * Ah * 1.4426950408889634f;
            float sc = a0 + a1, tot, c0, c1;
            if (dir == 0) {
#pragma unroll
                for (int o = 1; o < 64; o <<= 1) { const float t2 = __shfl_up(sc, o); if (lane >= o) sc += t2; }
                tot = __shfl(sc, 63); c0 = sc - a1; c1 = sc;
            } else {
#pragma unroll
                for (int o = 1; o < 64; o <<= 1) { const float t2 = __shfl_down(sc, o); if (lane + o < 64) sc += t2; }
                tot = __shfl(sc, 0); c0 = sc; c1 = sc - a0;
            }
            const size_t o2 = (size_t)dh * M + R0 + 2 * lane;
            *(F2*)(ACS2 + o2) = (F2){c0, c1}; *(F2*)(DTV + o2) = (F2){d0, d1};
            *(F2*)(WV + o2) = (F2){__builtin_amdgcn_exp2f(tot - c0) * d0, __builtin_amdgcn_exp2f(tot - c1) * d1};
            if (lane == 0) TOT[dh * 130 + c] = tot; }
        S8 cf[4];
#pragma unroll
        for (int ks = 0; ks < 4; ++ks) cf[ks] = *(const S8*)(XBC + (size_t)(128 * c + i) * 3072 + 2560 + 128 * g + 32 * ks + 8 * quad);
#pragma unroll
        for (int jt = 0; jt < 8; ++jt) {
            F4 acc = {0.f, 0.f, 0.f, 0.f};
#pragma unroll
            for (int ks = 0; ks < 4; ++ks) { const S8 bfr = *(const S8*)(XBC + (size_t)(128 * c + 16 * jt + il) * 3072 + 2048 + 128 * g + 32 * ks + 8 * quad);
                acc = __builtin_amdgcn_mfma_f32_16x16x32_bf16(bfr, cf[ks], acc, 0, 0, 0); }
            U2 o; o.x = pk2(acc[0], acc[1]); o.y = pk2(acc[2], acc[3]);
            *(U2*)(CB + (((size_t)c * 4 + g) * 128 + i) * 128 + 16 * jt + 4 * quad) = o;
        }
        __syncthreads();
        { const int n = tid >> 2, piece = tid & 3;
#pragma unroll
          for (int q = 0; q < 4; ++q) *(U4*)(BT + (((size_t)c * 4 + g) * 128 + n) * 128 + (piece * 4 + q) * 8) = *(const U4*)(T + n * 68 + (piece * 4 + q) * 4); }
    }
}
__device__ __forceinline__ int scan_chunk(int dir, int ci) { return dir == 0 ? ci : (ci < 2 ? 1 - ci : 131 - ci); }
__device__ __forceinline__ void phase_ssd_scan(const u16* XBC, const float* ACS2, const float* DTV, const float* WV, const float* TOT, const u16* CB, const u16* BT, u16* YF, u16* YB, u16* YDUMMY, unsigned char* lds, int bid, int G) {
    const int tid = TIDX(), lane = tid & 63, wave = __builtin_amdgcn_readfirstlane(tid >> 6), il = lane & 15, quad = lane >> 4;
    float* fb = (float*)lds;
    u16* XTb = (u16*)(lds + 4096);
    u16* HBFb = (u16*)(lds + 4096 + 4 * 4352);
    for (int it = bid; it < 256; it += G) {
        const int dir = it >> 7, h = (it & 127) >> 2, pq = it & 3, g = h >> 3;
        const size_t dhM = (size_t)(dir * 32 + h) * M; const float* totp = TOT + (dir * 32 + h) * 130;
        u16* Y = dir ? YB : YF;
        __syncthreads();
        for (int i = tid; i < 16 * 136; i += NTHR) HBFb[i] = 0;
        F4 hst = {0.f, 0.f, 0.f, 0.f};
        float pacs = 0.f, pdt = 0.f, pw = 0.f, ptot = 0.f; U4 pxr = {0u, 0u, 0u, 0u}; U4 pcf[4], pcb[4], pbt[4];
#pragma unroll
        for (int k = 0; k < 4; ++k) { pcf[k] = (U4){0u, 0u, 0u, 0u}; pcb[k] = (U4){0u, 0u, 0u, 0u}; pbt[k] = (U4){0u, 0u, 0u, 0u}; }
        const int xrow = (tid >> 1) & 127, xcol = h * 64 + pq * 16 + 8 * (tid & 1);
        const int irow = 16 * wave + il;
#define SCAN_PREF_A(cc) do { const size_t R0_ = (size_t)(cc) * 128; ptot = totp[cc]; \
            pxr = *(const U4*)(XBC + (R0_ + xrow) * 3072 + xcol); pw = WV[dhM + R0_ + xrow]; \
            pacs = ACS2[dhM + R0_ + (tid & 127)]; pdt = DTV[dhM + R0_ + (tid & 127)]; } while (0)
#define SCAN_PREF_B(cc) do { const size_t R0_ = (size_t)(cc) * 128; const size_t cg_ = ((size_t)(cc) * 4 + g) * 128 + irow; \
            _Pragma("unroll") for (int ks = 0; ks < 4; ++ks) { pbt[ks] = *(const U4*)(BT + cg_ * 128 + 32 * ks + 8 * quad); \
                pcf[ks] = *(const U4*)(XBC + (R0_ + irow) * 3072 + 2560 + 128 * g + 32 * ks + 8 * quad); pcb[ks] = *(const U4*)(CB + cg_ * 128 + 32 * ks + 8 * quad); } } while (0)
#define SCAN_STAGE(bsel) do { float* fbb = fb + (bsel) * 400; \
            if (wave < 4) { \
                if (wave < 2) { fbb[tid] = pacs; fbb[128 + tid] = pdt; if (tid == 0) fbb[384] = ptot; } \
                float f_[8]; unpack8(pxr, f_); u16* xt_ = XTb + (bsel) * (2 * 16 * 136); \
                _Pragma("unroll") for (int e = 0; e < 8; ++e) { const unsigned pw_ = pk2(f_[e], f_[e] * pw); xt_[(8 * (tid & 1) + e) * 136 + xrow] = (u16)(pw_ & 0xffffu); xt_[16 * 136 + (8 * (tid & 1) + e) * 136 + xrow] = (u16)(pw_ >> 16); } } } while (0)
        SCAN_PREF_A(scan_chunk(dir, 0)); SCAN_PREF_B(scan_chunk(dir, 0));
        SCAN_STAGE(0);
        SCAN_PREF_A(scan_chunk(dir, 1));
        for (int ci = 0; ci < 130; ++ci) {
            const int c = scan_chunk(dir, ci); const int bsel = ci & 1;
            const size_t R0 = (size_t)c * 128;
            const float* acs = fb + bsel * 400; const float* dtv = acs + 128; const u16* XT = XTb + bsel * (2 * 16 * 136); const u16* XTW = XT + 16 * 136; const u16* HBF = HBFb + bsel * (16 * 136);
            LDS_BAR();
            U4 cf[4], cbv[4], bt[4];
#pragma unroll
            for (int k = 0; k < 4; ++k) { cf[k] = pcf[k]; cbv[k] = pcb[k]; bt[k] = pbt[k]; }
            if (ci + 1 < 130) SCAN_PREF_B(scan_chunk(dir, ci + 1));
            const float tot = acs[384];
            {
                const int i = irow; const float acs_i = acs[i];
                F4 aoffv = {0.f, 0.f, 0.f, 0.f}, acc = {0.f, 0.f, 0.f, 0.f};
#pragma unroll
                for (int ks = 0; ks < 4; ++ks) { const S8 hf = *(const S8*)(HBF + il * 136 + 32 * ks + 8 * quad);
                    aoffv = __builtin_amdgcn_mfma_f32_16x16x32_bf16(hf, __builtin_bit_cast(S8, cf[ks]), aoffv, 0, 0, 0); }
                const int klo = dir == 0 ? 0 : (wave >> 1), khi = dir == 0 ? (wave >> 1) : 3;
#pragma unroll
                for (int ks = 0; ks < 4; ++ks) if (ks >= klo && ks <= khi) {
                    asm volatile("" ::: "memory");
                    float f[8]; unpack8(cbv[ks], f);
                    const int j0 = 32 * ks + 8 * quad;
                    const F4 aj0 = *(const F4*)(acs + j0), aj1 = *(const F4*)(acs + j0 + 4), dj0 = *(const F4*)(dtv + j0), dj1 = *(const F4*)(dtv + j0 + 4);
                    const float aj[8] = {aj0.x, aj0.y, aj0.z, aj0.w, aj1.x, aj1.y, aj1.z, aj1.w}, dj[8] = {dj0.x, dj0.y, dj0.z, dj0.w, dj1.x, dj1.y, dj1.z, dj1.w};
#pragma unroll
                    for (int e = 0; e < 8; ++e) { const int j = j0 + e; const bool ok = dir == 0 ? (j <= i) : (j >= i);
                        f[e] = f[e] * __builtin_amdgcn_exp2f(ok ? acs_i - aj[e] : -INFINITY) * dj[e]; }
                    const U4 gw = pack8(f); const S8 xf = *(const S8*)(XT + il * 136 + 32 * ks + 8 * quad);
                    acc = __builtin_amdgcn_mfma_f32_16x16x32_bf16(xf, __builtin_bit_cast(S8, gw), acc, 0, 0, 0);
                }
                const float ei = __builtin_amdgcn_exp2f(acs_i);
                U2 yo; yo.x = pk2(acc[0] + ei * aoffv[0], acc[1] + ei * aoffv[1]); yo.y = pk2(acc[2] + ei * aoffv[2], acc[3] + ei * aoffv[3]);
                u16* yp = c >= 2 ? Y + (R0 - CTX + irow) * 2048 + h * 64 + pq * 16 + 4 * quad : YDUMMY + tid * 4;
                *(U2*)yp = yo;
            }
            F4 sacc = {0.f, 0.f, 0.f, 0.f};
#pragma unroll
            for (int ks = 0; ks < 4; ++ks) { const S8 xa = *(const S8*)(XTW + il * 136 + 32 * ks + 8 * quad);
                sacc = __builtin_amdgcn_mfma_f32_16x16x32_bf16(xa, __builtin_bit_cast(S8, bt[ks]), sacc, 0, 0, 0); }
            hst = hst * __builtin_amdgcn_exp2f(tot) + sacc;
            if (ci + 1 < 130) { SCAN_STAGE(bsel ^ 1); if (ci + 2 < 130) SCAN_PREF_A(scan_chunk(dir, ci + 2)); }
#pragma unroll
            for (int r = 0; r < 4; ++r) HBFb[(bsel ^ 1) * (16 * 136) + (4 * quad + r) * 136 + 16 * wave + il] = (u16)f2bf(hst[r]);
        }
#undef SCAN_PREF_A
#undef SCAN_PREF_B
#undef SCAN_STAGE
    }
}
constexpr int NPHASES = 38;
enum { K_NONE = 0, K_STORE, K_GM, K_SSDIN, K_SWIGLU, K_RESID };
__device__ __forceinline__ size_t w_fi(int ly) { return ly == 0 ? W_FI0 : ly == 1 ? W_FI1 : ly == 2 ? W_FI2 : W_FI3; }
__device__ __forceinline__ size_t w_fo(int ly) { return ly == 0 ? W_FO0 : ly == 1 ? W_FO1 : ly == 2 ? W_FO2 : W_FO3; }

__device__ __forceinline__ void run_phase(const Args& a, int ph, unsigned char* lds, int bid, int G) {
    unsigned char* ws = a.ws;
    float* X = (float*)(ws + WS_X); u16* H = (u16*)(ws + WS_H); float* MOD = (float*)(ws + WS_MOD);
    unsigned char* outb = (unsigned char*)a.out;
    float* PART = (float*)(ws + WS_PART);
    int kind = K_NONE; const u16* gA = nullptr; const u16* gB = nullptr; int gM = M, gN = 0, gK = 0;
    u16* gdst = nullptr; int gldc = 0; float* gX = X; const float* gl = nullptr; const float* gc = nullptr; int gctx = 1;
    const int ly = ph <= 8 ? 0 : ph <= 16 ? 1 : ph <= 26 ? 2 : 3;
    const float* modL = MOD + (size_t)(ly * 2 + 0) * 6144; const float* modC = MOD + (size_t)(ly * 2 + 1) * 6144;
    const int ffn0 = ly == 0 ? 6 : ly == 1 ? 14 : ly == 2 ? 24 : 34;
    const int n1 = ly == 0 ? 1 : ly == 1 ? 9 : ly == 2 ? 17 : 27;
    const bool latonly = (ly == 3);
    if (ph == 0) { phase_prologue(a, lds, bid, G); }
    else if (ph == n1) {
        if (ly == 0) phase_norm_mod((float*)a.in[I_CTX], a.in[I_X], X, a.in[I_N1G], modL, modC, 0, 1024, H, 0, nullptr, 0, nullptr, bid, G);
        else phase_norm_mod(X, X + (size_t)CTX * D, nullptr, a.in[I_N1G] + ly * D, modL, modC, 0, 1024, H, 0, PART, 11, MOD + (size_t)((ly - 1) * 2 + 1) * 6144 + 5120, bid, G);
    }
    else if (ph == ffn0) { phase_norm_mod(X, X + (size_t)CTX * D, nullptr, a.in[I_N2G] + ly * D, modL, modC, 3072, 4096, H, latonly ? CTX : 0, latonly ? nullptr : PART, ly == 0 ? 8 : 4, modC + 2048, bid, G); }
    else if (ph == ffn0 + 1) { kind = K_SWIGLU; gA = H + (latonly ? (size_t)CTX * D : 0); gB = (const u16*)(ws + w_fi(ly)); gM = latonly ? L : M; gN = 5632; gK = 1024; gdst = (u16*)(ws + B_ACT); }
    else if (ph == ffn0 + 2) { kind = K_RESID; gA = (const u16*)(ws + B_ACT); gB = (const u16*)(ws + w_fo(ly)); gM = latonly ? L : M; gN = 1024; gK = 2816;
        gX = X + (latonly ? (size_t)CTX * D : 0); gl = modL + 5120; gc = modC + 5120; gctx = latonly ? 0 : 1; }
    else switch (ph) {
        case 2: kind = K_GM; gA = H; gB = (const u16*)(ws + W_GMI); gN = 4096; gK = 1024; break;
        case 4: phase_spatial((u16*)(ws + B_U), (const u16*)(ws + B_V), (const float*)(ws + WS_STATSP), a.in[I_GMWS], a.in[I_GMBS], a.in[I_GMLG], a.in[I_GMLB], lds, bid, G); break;
        case 5: kind = K_RESID; gA = (const u16*)(ws + B_U); gB = (const u16*)(ws + W_GMO); gN = 1024; gK = 2048; gl = modL + 2048; gc = modC + 2048; break;
        case 10: kind = K_STORE; gA = H; gB = (const u16*)(ws + W_QKV); gN = 1536; gK = 1024; gdst = (u16*)(ws + B_QKVR); gldc = 1536; break;
        case 11: phase_qk_rope((const u16*)(ws + B_QKVR), a.in[I_ATQG], a.in[I_ATKG], (u16*)(ws + B_Q), (u16*)(ws + B_K), (u16*)(ws + B_VV), bid, G); break;
        case 12: phase_attention((const u16*)(ws + B_Q), (const u16*)(ws + B_K), (const u16*)(ws + B_VV), (u16*)(ws + B_QKVR), lds, bid, G); break;
        case 13: kind = K_RESID; gA = (const u16*)(ws + B_QKVR); gB = (const u16*)(ws + W_ATO); gN = 1024; gK = 1024; gl = modL + 2048; gc = modC + 2048; break;
        case 18: kind = K_STORE; gA = H; gB = (const u16*)(ws + W_HYI); gN = 3072; gK = 1024; gdst = (u16*)(ws + B_P); gldc = 3072; break;
        case 19: phase_hy_dwconv((const u16*)(ws + B_P), a.in[I_HYCW], a.in[I_HYCB], (u16*)(ws + B_X0), (u16*)(ws + B_UT), lds, bid, G); break;
        case 21: phase_hy_conv((const u16*)(outb + OUT_KK), (const u16*)(ws + B_UT), (u16*)(ws + B_YT), (const float*)(ws + WS_HID2), a.in[I_HYW3], a.in[I_HYSK], lds, bid, G); break;
        case 22: phase_hy_tgate((u16*)(ws + B_X0), (const u16*)(ws + B_YT), lds, bid, G); break;
        case 23: kind = K_RESID; gA = (const u16*)(ws + B_X0); gB = (const u16*)(ws + W_HYO); gN = 1024; gK = 1024; gl = modL + 2048; gc = modC + 2048; break;
        case 28: kind = K_SSDIN; gA = H; gB = (const u16*)(ws + W_SSI); gN = 5376; gK = 1024; break;
        case 29: phase_ssd_conv((u16*)(ws + B_XBC), (const u16*)(outb + OUT_HALO), a.in[I_SSCW], a.in[I_SSCB], bid, G); break;
        case 30: phase_ssd_cb((const u16*)(ws + B_XBC), (u16*)(ws + WS_CB), (u16*)(ws + WS_BT), (const float*)(ws + B_DT), a.in[I_SSAL], a.in[I_SSDB], (float*)(ws + WS_ACS2), (float*)(ws + WS_DTV), (float*)(ws + WS_WV), (float*)(ws + WS_TOT), lds, bid, G); break;
        case 31: phase_ssd_scan((const u16*)(ws + B_XBC), (const float*)(ws + WS_ACS2), (const float*)(ws + WS_DTV), (const float*)(ws + WS_WV), (const float*)(ws + WS_TOT), (const u16*)(ws + WS_CB), (const u16*)(ws + WS_BT), (u16*)(ws + WS_YF), (u16*)outb, (u16*)(ws + 16384), lds, bid, G); break;
        case 32: phase_ssd_finish((const u16*)(ws + WS_YF), (const u16*)outb, (const u16*)(ws + B_XBC), (u16*)(ws + B_Z), a.in[I_SSDS], a.in[I_SSNG], bid, G); break;
        case 33: kind = K_RESID; gA = (const u16*)(ws + B_Z) + (size_t)CTX * 2048; gB = (const u16*)(ws + W_SSO); gM = L; gN = 1024; gK = 2048; gX = X + (size_t)CTX * D; gl = modL + 2048; gc = modC + 2048; gctx = 0; break;
        case 37: phase_final(X, a.in[I_FING], a.out, bid, G); break;
        default: break;
    }
    if (kind != K_NONE) {
        const bool split = (kind == K_RESID) && gctx;
        if (split) { gA += (size_t)CTX * gK; gM = L; gX = X + (size_t)CTX * D; gctx = 0; }
        pg8::Gemm g{gA, gB, gM, gN, gK, gK}; pg8::StaticOrder S; S.init(gM, gN, G, bid);
        PG8_LAS unsigned char* l3 = (PG8_LAS unsigned char*)lds;
        if (kind == K_STORE) { pg8::EpiStore<0, pg8::RouterSimple> E{pg8::RouterSimple{gdst, gldc}}; pg8::gemm_phase<pg8::EpiStore<0, pg8::RouterSimple>, pg8::StaticOrder, true, true>(l3, g, S, E);
            if (ph == 10 && bid >= 134) convert_layer(a, 3, lds, bid - 134, G - 134);
            if (ph == 18) phase_hy_ktgen((const float*)(ws + WS_HID2), a.in[I_HYW3], a.in[I_HYSK], (u16*)(outb + OUT_KK), lds, bid, G); }
        else if (kind == K_GM) { pg8::EpiGmIn E{(u16*)(ws + B_U), (u16*)(ws + B_V), (float*)(ws + WS_STATSP)}; pg8::gemm_phase<pg8::EpiGmIn, pg8::StaticOrder, true, true>(l3, g, S, E);
            if (bid >= 16) convert_layer(a, 1, lds, bid - 16, G - 16); }
        else if (kind == K_SSDIN) { pg8::EpiSsdIn E{(u16*)(ws + B_Z), (u16*)(ws + B_XBC), (float*)(ws + B_DT), (u16*)(outb + OUT_HALO)}; pg8::gemm_phase<pg8::EpiSsdIn, pg8::StaticOrder, true, true>(l3, g, S, E); }
        else if (kind == K_SWIGLU) { pg8::EpiSwiglu E{gdst}; pg8::gemm_phase<pg8::EpiSwiglu, pg8::StaticOrder, true, true>(l3, g, S, E);
            if (ph == 7 && bid >= 150) convert_layer(a, 2, lds, bid - 150, G - 150); }
        else {
            if (split) { pg8::Gemm g2{gA - (size_t)CTX * gK, gB, CTX, gN, gK, 256}; pg8::SplitKOrder S2; S2.init(gN, gK / 256, G, bid); pg8::EpiPartial E2{PART};
                pg8::gemm_phase<pg8::EpiPartial, pg8::SplitKOrder, false, true>(l3, g2, S2, E2);
                __builtin_amdgcn_sched_barrier(0); }
            pg8::EpiResid E{gX, gl, gc, gctx}; pg8::gemm_phase<pg8::EpiResid, pg8::StaticOrder, true, true>(l3, g, S, E); }
    }
}

#define XB_TMO      128
#define XB_XCNT(j)  (256  + 64 * (j))
#define XB_XSUB(j)  (1280 + 64 * (j))
#define XB_XGEN(j)  (2304 + 64 * (j))
#define XB_TOP      3328
#define XB_TOPGEN   3392
#define XCD_BAR_WORDS 3456
#define XB_SPIN_CAP (1u << 18)

__device__ __forceinline__ unsigned xb_ld(unsigned* p)              { return __hip_atomic_load(p, __ATOMIC_RELAXED, __HIP_MEMORY_SCOPE_AGENT); }
__device__ __forceinline__ unsigned xb_add(unsigned* p, unsigned v) { return __hip_atomic_fetch_add(p, v, __ATOMIC_RELAXED, __HIP_MEMORY_SCOPE_AGENT); }
__device__ __forceinline__ unsigned xb_xcc_id() { return (unsigned)__builtin_amdgcn_s_getreg((3 << 11) | 20) & 0xFu; }
#define XB_SPIN(cond, bar) do { unsigned _sp = 0; while (cond) { __builtin_amdgcn_s_sleep(1); \
    if ((++_sp & 255u) == 0u) { if (xb_ld(&(bar)[XB_TMO])) break; if (_sp > XB_SPIN_CAP) { atomicAdd(&(bar)[XB_TMO], 1u); break; } } } } while (0)

struct XcdBarrier {
    unsigned* bar; unsigned x;
    volatile LAS unsigned* st;
};

__device__ __forceinline__ XcdBarrier xcd_barrier_post(unsigned* bar, volatile LAS unsigned* st) {
    XcdBarrier b; b.bar = bar; b.x = xb_xcc_id(); b.st = st;
    if (TIDX() == 0) (void)xb_add(&bar[XB_XCNT(b.x)], 1u);
    return b;
}
__device__ __forceinline__ void xcd_barrier_complete(unsigned* bar, unsigned x, unsigned& nloc, unsigned& nx) {
    const unsigned G = gridDim.x * gridDim.y * gridDim.z;
    unsigned sum, cnt, mine, sp = 0u;
    for (;;) {
        sum = 0u; cnt = 0u; mine = 0u;
#pragma unroll
        for (unsigned j = 0; j < 16; ++j) { const unsigned c = xb_ld(&bar[XB_XCNT(j)]); sum += c; cnt += (c > 0u) ? 1u : 0u; mine = (j == x) ? c : mine; }
        if (sum == G) break;
        __builtin_amdgcn_s_sleep(1);
        if ((++sp & 255u) == 0u) { if (xb_ld(&bar[XB_TMO])) break; if (sp > XB_SPIN_CAP) { atomicAdd(&bar[XB_TMO], 1u); break; } }
    }
    nloc = mine > 0u ? mine : 1u; nx = cnt > 0u ? cnt : 1u;
}

__device__ __forceinline__ void xcd_barrier(const XcdBarrier& b) {
    asm volatile("s_waitcnt vmcnt(0)" ::: "memory");
    __syncthreads();
    if (TIDX() == 0) {
        unsigned* bar = b.bar;
        __builtin_amdgcn_s_waitcnt(0);
        unsigned nloc = b.st[0], nx = b.st[1];
        if (nloc == 0u) { xcd_barrier_complete(bar, b.x, nloc, nx); b.st[0] = nloc; b.st[1] = nx; }
        const unsigned old = xb_add(&bar[XB_XSUB(b.x)], 1u);
        const unsigned gen = old / nloc;
        if (old + 1u == (gen + 1u) * nloc) {
            __builtin_amdgcn_fence(__ATOMIC_RELEASE, "agent");
            asm volatile("s_waitcnt vmcnt(0)" ::: "memory");
            const unsigned og = xb_add(&bar[XB_TOP], 1u);
            const unsigned tg = og / nx;
            if (og + 1u == (tg + 1u) * nx) xb_add(&bar[XB_TOPGEN], 1u);
            else XB_SPIN(xb_ld(&bar[XB_TOPGEN]) == tg, bar);
            __builtin_amdgcn_fence(__ATOMIC_ACQUIRE, "agent");
            xb_add(&bar[XB_XGEN(b.x)], 1u);
            asm volatile("s_waitcnt vmcnt(0)" ::: "memory");
        } else {
            XB_SPIN(xb_ld(&bar[XB_XGEN(b.x)]) == gen, bar);
            __builtin_amdgcn_fence(__ATOMIC_ACQUIRE, "agent");
            asm volatile("s_waitcnt vmcnt(0)" ::: "memory");
        }
    }
    __syncthreads();
}


#if MK_MULTI_LAUNCH
template <int PH> __global__ void __launch_bounds__(NTHR, 2) k_phase(Args a) {
    extern __shared__ __attribute__((aligned(16))) unsigned char lds[];
    run_phase(a, PH, lds, blockIdx.x, gridDim.x);
}
typedef void (*phase_kernel_t)(Args);
template <int... I> static void fill_table(phase_kernel_t* t, std::integer_sequence<int, I...>) { ((t[I] = k_phase<I>), ...); }
#define MEGA_K k_phase<0>
#else
typedef const __attribute__((address_space(4))) Args* kargs_t;
constexpr int MISC_OFF = LDS_BYTES - 128;
template <int PH> __device__ __forceinline__ void run_from(unsigned char* lds, const XcdBarrier& bar) {
    if constexpr (PH == 3 || PH == 20) { run_from<PH + 1>(lds, bar); }
    else if constexpr (PH < NPHASES) {
        {
#if defined(__HIP_DEVICE_COMPILE__)
            kargs_t ap = (kargs_t)__builtin_amdgcn_kernarg_segment_ptr();
            asm volatile("" : "+s"(ap));
            Args la;
            for (int i = 0; i < 40; ++i) la.in[i] = ap->in[i];
            la.out = ap->out; la.ws = ap->ws; la.ph_lo = 0; la.ph_hi = NPHASES;
            run_phase(la, PH, lds, blockIdx.x, gridDim.x);
#if defined(PROBE_REPEAT)
            if constexpr (PROBE_REPEAT(PH)) { xcd_barrier(bar); run_phase(la, PH, lds, blockIdx.x, gridDim.x); }
#endif
#endif
        }
        if constexpr (PH + 1 < NPHASES) {
            if constexpr (PH == 0) cg::this_grid().sync(); else xcd_barrier(bar);
            run_from<PH + 1>(lds, bar);
        }
    }
}
__global__ void __launch_bounds__(NTHR, 2) mega_fwd(Args a) {
    extern __shared__ __attribute__((aligned(16))) unsigned char lds[];
    volatile LAS unsigned* misc = (volatile LAS unsigned*)((LAS unsigned char*)lds + MISC_OFF);
    if (TIDX() < 32) misc[TIDX()] = 0u;
    if (blockIdx.x == 0) { unsigned* bw = (unsigned*)a.ws; for (int i = TIDX(); i < XCD_BAR_WORDS; i += NTHR) bw[i] = 0u; }
    __syncthreads();
    {
#if defined(__HIP_DEVICE_COMPILE__)
        kargs_t ap = (kargs_t)__builtin_amdgcn_kernarg_segment_ptr();
        asm volatile("" : "+s"(ap));
        Args la;
        for (int i = 0; i < 40; ++i) la.in[i] = ap->in[i];
        la.out = ap->out; la.ws = ap->ws; la.ph_lo = 0; la.ph_hi = NPHASES;
        run_phase(la, 0, lds, blockIdx.x, gridDim.x);
#endif
    }
    cg::this_grid().sync();
    const XcdBarrier bar = xcd_barrier_post((unsigned*)a.ws, misc + 8);
    run_from<1>(lds, bar);
}
#define MEGA_K mega_fwd
#endif

extern "C" void kernel_launch(void* const* d_in, const int* in_sizes, int n_in, void* d_out, int out_size, void* d_ws, size_t ws_size, hipStream_t stream) {
    static int grid = 0;
    if (grid == 0) {
        if (n_in != 40 || out_size != L * D || ws_size < WS_END) { fprintf(stderr, "kernel_launch: unexpected shapes (n_in %d, out %d, ws %zu, need %zu)\n", n_in, out_size, ws_size, (size_t)WS_END); grid = -1; return; }
        int dev = 0, cus = 0, per_cu = 0;
        (void)hipGetDevice(&dev); (void)hipDeviceGetAttribute(&cus, hipDeviceAttributeMultiprocessorCount, dev);
        if (hipFuncSetAttribute((const void*)MEGA_K, hipFuncAttributeMaxDynamicSharedMemorySize, LDS_BYTES) != hipSuccess) { fprintf(stderr, "kernel_launch: hipFuncSetAttribute failed\n"); grid = -1; return; }
        if (hipOccupancyMaxActiveBlocksPerMultiprocessor(&per_cu, (const void*)MEGA_K, NTHR, LDS_BYTES) != hipSuccess || per_cu < 1) per_cu = 1;
        (void)hipGetLastError();
        grid = cus * per_cu;
        if (grid <= 0) grid = 256;
    }
    if (grid < 0) return;
    Args a{};
    for (int i = 0; i < 40; ++i) a.in[i] = (const float*)d_in[i];
    a.out = (float*)d_out; a.ws = (unsigned char*)d_ws;
#if MK_MULTI_LAUNCH
    static phase_kernel_t table[NPHASES]; static bool tinit = false;
    if (!tinit) { fill_table(table, std::make_integer_sequence<int, NPHASES>{}); for (int ph = 0; ph < NPHASES; ++ph) (void)hipFuncSetAttribute((const void*)table[ph], hipFuncAttributeMaxDynamicSharedMemorySize, LDS_BYTES); tinit = true; }
    for (int ph = 0; ph < NPHASES; ++ph) { a.ph_lo = ph; a.ph_hi = ph + 1; hipLaunchKernelGGL(table[ph], dim3(grid), dim3(NTHR), LDS_BYTES, stream, a); }
#else
    a.ph_lo = 0; a.ph_hi = NPHASES;
    void* args[] = {&a};
    hipError_t e = hipLaunchCooperativeKernel((const void*)mega_fwd, dim3(grid), dim3(NTHR), args, LDS_BYTES, stream);
    if (e != hipSuccess) fprintf(stderr, "cooperative launch failed: %s (grid %d)\n", hipGetErrorString(e), grid);
#endif
}
```

```cpp
#include <hip/hip_runtime.h>
#include <hip/hip_cooperative_groups.h>
#include <hip/hip_bf16.h>
#include <cstdio>
#include <cstdint>
#include <cmath>
#include <utility>
namespace cg = cooperative_groups;
__device__ __forceinline__ int TIDX() { int t = threadIdx.x; asm volatile("" : "+v"(t)); return t; }
#ifndef MK_MULTI_LAUNCH
#define MK_MULTI_LAUNCH 0
#endif
__device__ __forceinline__ float silu_f(float x) { return x * __builtin_amdgcn_rcpf(1.0f + __expf(-x)); }
namespace pg8 {
#define PG8_LAS __attribute__((address_space(3)))
typedef unsigned short bf16_t;
typedef short bf16x8 __attribute__((ext_vector_type(8)));
typedef float f32x4 __attribute__((ext_vector_type(4)));
typedef unsigned u32x4 __attribute__((ext_vector_type(4)));
constexpr int BM = 256, BK = 64, HALF = 128, HTB = HALF * BK * 2  , STAGE_BYTES = 8 * HTB, NXCD = 8, WGM = 8;

__host__ __device__ __forceinline__ int lds_byte(int r, int c) { const int st = (r >> 4) * 2 + (c >> 5), rr = r & 15, cc = c & 31, ob = rr * 64 + cc * 2; return st * 1024 + (ob ^ (((ob >> 9) & 1) << 5)); }
__host__ __device__ __forceinline__ void stage_rc(int b, int& R, int& C) { const int st = b / 1024, sb = b % 1024, swz = sb ^ (((sb >> 9) & 1) << 5); R = (st >> 1) * 16 + swz / 64; C = (st & 1) * 32 + (swz % 64) / 2; }
__host__ __device__ __forceinline__ int perm32(int rho) { const int n = rho >> 4, i = rho & 15; return 8 * (i >> 2) + 4 * n + (i & 3); }

struct Unit { int pm, pn, kz; };
struct Gemm { const bf16_t* A; const bf16_t* Bt; int M, N, K, kloop; };

struct StaticOrder {
    int nM, nN, nwg, G, c;
    __host__ __device__ void init(int M, int N, int G_, int c_) { nM = M / BM; nN = N / BM; nwg = nM * nN; G = G_; c = c_; }
    __host__ __device__ bool next(int i, Unit& u) const {
        const long L = (long)i * G + c; if (L >= nwg) return false;
        int wgid = (int)L; { const int q = nwg / NXCD, r = nwg % NXCD, xcd = wgid % NXCD, off = wgid / NXCD; wgid = (xcd < r ? xcd * (q + 1) : r * (q + 1) + (xcd - r) * q) + off; }
        const int nig = WGM * nN, gid = wgid / nig, fm = gid * WGM, gsz = (nM - fm) < WGM ? (nM - fm) : WGM;
        u.pm = fm + ((wgid % nig) % gsz); u.pn = (wgid % nig) / gsz; u.kz = 0; return true;
    }
    __device__ __forceinline__ void a_ready(const Unit&) const {}
    __device__ __forceinline__ void done(const Unit&) const {}
};

__device__ __forceinline__ unsigned cvt_pk_bf16(float lo, float hi) { unsigned r; asm volatile("v_cvt_pk_bf16_f32 %0, %1, %2" : "=v"(r) : "v"(lo), "v"(hi)); return r; }
typedef float f32x2 __attribute__((ext_vector_type(2)));
__device__ __forceinline__ f32x2 gelu_pk(f32x2 v) {
    const f32x2 av = __builtin_elementwise_abs(v), d = av * 0.2316418882f + 1.0f;
    f32x2 t; t.x = __builtin_amdgcn_rcpf(d.x); t.y = __builtin_amdgcn_rcpf(d.y);
    f32x2 q = t * 0.5307027145f + (-0.7265760135f); q = q * t + 0.7107068705f; q = q * t + (-0.142248368f); q = q * t + 0.127414796f; q = q * t;
    const f32x2 s = (v * v) * (-0.72134752044f);
    f32x2 e; e.x = __builtin_amdgcn_exp2f(s.x); e.y = __builtin_amdgcn_exp2f(s.y);
    const f32x2 m = v * (q * e), r = v - m;
    f32x2 o; o.x = v.x < 0.f ? m.x : r.x; o.y = v.y < 0.f ? m.y : r.y; return o;
}

typedef unsigned u32x2 __attribute__((ext_vector_type(2)));

struct Route { bf16_t* base; int ldc; int col; };
struct RouterSimple { bf16_t* O; int ldc; __device__ __forceinline__ Route operator()(int pn) const { return Route{O, ldc, pn * BM}; } };
struct RouterGm { bf16_t* U; bf16_t* V; __device__ __forceinline__ Route operator()(int pn) const { return pn < 8 ? Route{U, 2048, pn * BM} : Route{V, 2048, (pn - 8) * BM}; } };
template <int ACT, class Router> struct EpiStore {
    static constexpr bool PERM = true, AFTER_DRAIN = false;
    Router R;
    __device__ __forceinline__ void operator()(const f32x4 (&acc)[2][2][4][2], const Unit& u, int wr, int wc, int fr, int fq) const {
        const int row0 = u.pm * BM + wr * 64 + fr; const Route rt = R(u.pn);
        const int col0 = rt.col + wc * 32 + 8 * fq;
#pragma unroll
        for (int ai = 0; ai < 2; ++ai)
#pragma unroll
            for (int m = 0; m < 4; ++m) { bf16_t* rowp = rt.base + (size_t)(row0 + ai * HALF + m * 16) * rt.ldc + col0;
#pragma unroll
                for (int bj = 0; bj < 2; ++bj) { f32x4 v0 = acc[ai][bj][m][0], v1 = acc[ai][bj][m][1];
                    if (ACT == 1) { f32x2 a = gelu_pk((f32x2){v0[0], v0[1]}), b = gelu_pk((f32x2){v0[2], v0[3]}), c = gelu_pk((f32x2){v1[0], v1[1]}), d = gelu_pk((f32x2){v1[2], v1[3]});
                        v0 = (f32x4){a.x, a.y, b.x, b.y}; v1 = (f32x4){c.x, c.y, d.x, d.y}; }
                    u32x4 w; w.x = cvt_pk_bf16(v0[0], v0[1]); w.y = cvt_pk_bf16(v0[2], v0[3]); w.z = cvt_pk_bf16(v1[0], v1[1]); w.w = cvt_pk_bf16(v1[2], v1[3]);
                    *(u32x4*)(rowp + bj * HALF) = w; } }
    }
};
struct EpiGmIn {
    static constexpr bool PERM = true, AFTER_DRAIN = false;
    bf16_t* U; bf16_t* V; float* STATS;
    __device__ __forceinline__ void operator()(const f32x4 (&acc)[2][2][4][2], const Unit& u, int wr, int wc, int fr, int fq) const {
        const int row0 = u.pm * BM + wr * 64 + fr; const bool isv = u.pn >= 8;
        bf16_t* base = isv ? V : U; const int col0 = (isv ? u.pn - 8 : u.pn) * BM + wc * 32 + 8 * fq;
#pragma unroll
        for (int ai = 0; ai < 2; ++ai)
#pragma unroll
            for (int m = 0; m < 4; ++m) { const int row = row0 + ai * HALF + m * 16; bf16_t* rowp = base + (size_t)row * 2048 + col0; float s = 0.f, q = 0.f;
#pragma unroll
                for (int bj = 0; bj < 2; ++bj) { f32x4 v0 = acc[ai][bj][m][0], v1 = acc[ai][bj][m][1];
                    f32x2 a = gelu_pk((f32x2){v0[0], v0[1]}), b = gelu_pk((f32x2){v0[2], v0[3]}), c = gelu_pk((f32x2){v1[0], v1[1]}), d = gelu_pk((f32x2){v1[2], v1[3]});
                    u32x4 w; w.x = cvt_pk_bf16(a.x, a.y); w.y = cvt_pk_bf16(b.x, b.y); w.z = cvt_pk_bf16(c.x, c.y); w.w = cvt_pk_bf16(d.x, d.y);
                    *(u32x4*)(rowp + bj * HALF) = w;
                    s += ((a.x + a.y) + (b.x + b.y)) + ((c.x + c.y) + (d.x + d.y));
                    q += ((a.x * a.x + a.y * a.y) + (b.x * b.x + b.y * b.y)) + ((c.x * c.x + c.y * c.y) + (d.x * d.x + d.y * d.y)); }
                if (isv) { s += __shfl_xor(s, 16); s += __shfl_xor(s, 32); q += __shfl_xor(q, 16); q += __shfl_xor(q, 32);
                    if (fq == 0) { float* sp = STATS + (((size_t)row * 8 + (u.pn - 8)) * 4 + wc) * 2; sp[0] = s; sp[1] = q; } } }
    }
};
struct EpiSwiglu {
    static constexpr bool PERM = true, AFTER_DRAIN = false;
    bf16_t* O;
    __device__ __forceinline__ void operator()(const f32x4 (&acc)[2][2][4][2], const Unit& u, int wr, int wc, int fr, int fq) const {
        const int row0 = u.pm * BM + wr * 64 + fr; const int col0 = u.pn * HALF + wc * 32 + 8 * fq;
#pragma unroll
        for (int ai = 0; ai < 2; ++ai)
#pragma unroll
            for (int m = 0; m < 4; ++m) { bf16_t* rowp = O + (size_t)(row0 + ai * HALF + m * 16) * 2816 + col0;
                const f32x4 g0 = acc[ai][0][m][0], g1 = acc[ai][0][m][1], u0 = acc[ai][1][m][0], u1 = acc[ai][1][m][1];
                u32x4 w; w.x = cvt_pk_bf16(silu_f(g0[0]) * u0[0], silu_f(g0[1]) * u0[1]); w.y = cvt_pk_bf16(silu_f(g0[2]) * u0[2], silu_f(g0[3]) * u0[3]);
                w.z = cvt_pk_bf16(silu_f(g1[0]) * u1[0], silu_f(g1[1]) * u1[1]); w.w = cvt_pk_bf16(silu_f(g1[2]) * u1[2], silu_f(g1[3]) * u1[3]);
                *(u32x4*)rowp = w; }
    }
};
struct EpiResid {
    static constexpr bool PERM = false, AFTER_DRAIN = false;
    float* X; const float* gate_lat; const float* gate_ctx; int ctx_tile; const float* Xsrc;
    __device__ __forceinline__ void operator()(const f32x4 (&acc)[2][2][4][2], const Unit& u, int wr, int wc, int fr, int fq) const {
        const int row0 = u.pm * BM + wr * 64 + fr; const int col0 = u.pn * BM + wc * 32 + 4 * fq;
        const float* gate = (ctx_tile && u.pm == 0) ? gate_ctx : gate_lat;
        f32x4 gv[2][2];
#pragma unroll
        for (int bj = 0; bj < 2; ++bj)
#pragma unroll
            for (int n = 0; n < 2; ++n) gv[bj][n] = *(const f32x4*)(gate + col0 + bj * HALF + 16 * n);
#pragma unroll
        for (int ai = 0; ai < 2; ++ai)
#pragma unroll
            for (int m = 0; m < 4; ++m) { const size_t ro = (size_t)(row0 + ai * HALF + m * 16) * 1024 + col0;
#pragma unroll
                for (int bj = 0; bj < 2; ++bj)
#pragma unroll
                    for (int n = 0; n < 2; ++n) { const size_t o = ro + bj * HALF + 16 * n; *(f32x4*)(X + o) = *(const f32x4*)(Xsrc + o) + gv[bj][n] * acc[ai][bj][m][n]; } }
    }
};
struct SplitKOrder {
    int nN, nks, G, c;
    __host__ __device__ void init(int N, int nks_, int G_, int c_) { nN = N / BM; nks = nks_; G = G_; c = c_; }
    __host__ __device__ bool next(int i, Unit& u) const { const long L = (long)i * G + c; if (L >= (long)nN * nks) return false; u.pm = 0; u.pn = (int)(L % nN); u.kz = (int)(L / nN); return true; }
    __device__ __forceinline__ void a_ready(const Unit&) const {}
    __device__ __forceinline__ void done(const Unit&) const {}
};
struct EpiPartial {
    static constexpr bool PERM = false, AFTER_DRAIN = false;
    float* P;
    __device__ __forceinline__ void operator()(const f32x4 (&acc)[2][2][4][2], const Unit& u, int wr, int wc, int fr, int fq) const {
        const int row0 = wr * 64 + fr; const int col0 = u.pn * BM + wc * 32 + 4 * fq;
#pragma unroll
        for (int ai = 0; ai < 2; ++ai)
#pragma unroll
            for (int m = 0; m < 4; ++m) { float* prow = P + ((size_t)u.kz * 256 + row0 + ai * HALF + m * 16) * 1024 + col0;
#pragma unroll
                for (int bj = 0; bj < 2; ++bj)
#pragma unroll
                    for (int n = 0; n < 2; ++n) *(f32x4*)(prow + bj * HALF + 16 * n) = acc[ai][bj][m][n]; }
    }
};
struct EpiSsdIn {
    static constexpr bool PERM = true, AFTER_DRAIN = false;
    bf16_t* Z; bf16_t* XBC; float* DT; bf16_t* HALO;
    __device__ __forceinline__ void operator()(const f32x4 (&acc)[2][2][4][2], const Unit& u, int wr, int wc, int fr, int fq) const {
        const int row0 = u.pm * BM + wr * 64 + fr; const int pn = u.pn;
        if (pn < 20) {
            bf16_t* base = pn < 8 ? Z : XBC; const int ldc = pn < 8 ? 2048 : 3072; const int col0 = (pn < 8 ? pn : pn - 8) * BM + wc * 32 + 8 * fq;
#pragma unroll
            for (int ai = 0; ai < 2; ++ai)
#pragma unroll
                for (int m = 0; m < 4; ++m) { const int row = row0 + ai * HALF + m * 16; bf16_t* rowp = base + (size_t)row * ldc + col0; const int rl = row & 31;
#pragma unroll
                    for (int bj = 0; bj < 2; ++bj) { const f32x4 v0 = acc[ai][bj][m][0], v1 = acc[ai][bj][m][1];
                        u32x4 w; w.x = cvt_pk_bf16(v0[0], v0[1]); w.y = cvt_pk_bf16(v0[2], v0[3]); w.z = cvt_pk_bf16(v1[0], v1[1]); w.w = cvt_pk_bf16(v1[2], v1[3]);
                        *(u32x4*)(rowp + bj * HALF) = w;
                        if (pn >= 8 && (rl == 0 || rl == 31)) *(u32x4*)(HALO + ((size_t)(row >> 5) * 2 + (rl == 31 ? 1 : 0)) * 3072 + col0 + bj * HALF) = w; } }
        } else if (wc < 2) {
#pragma unroll
            for (int ai = 0; ai < 2; ++ai)
#pragma unroll
                for (int m = 0; m < 4; ++m) { float* rowp = DT + (size_t)(row0 + ai * HALF + m * 16) * 64 + wc * 32 + 8 * fq;
                    *(f32x4*)rowp = acc[ai][0][m][0]; *(f32x4*)(rowp + 4) = acc[ai][0][m][1]; }
        }
    }
};
template <class Epi, class Sched, bool ALIGN_EPI = false, bool SP2 = false>
__device__ __forceinline__ void gemm_phase(PG8_LAS unsigned char* lds, const Gemm g, const Sched& S, const Epi& E) {
    const int tid = TIDX(), wid = __builtin_amdgcn_readfirstlane(tid >> 6), lane = tid & 63, wr = wid >> 2, wc = wid & 3, fr = lane & 15, fq = lane >> 4;
    const int K = g.K, nt = g.kloop / BK; const size_t kzb = (size_t)g.kloop * 2;
    unsigned voffA[2], voffB[2];
#pragma unroll
    for (int i = 0; i < 2; ++i) { int R, C; stage_rc(tid * 16 + i * 8192, R, C); const int Rb = Epi::PERM ? ((R & ~31) + perm32(R & 31)) : R;
        voffA[i] = (unsigned)(R * K + C) * 2u; voffB[i] = (unsigned)(Rb * K + C) * 2u; }
    const size_t kstep = (size_t)(BK * 2);
    const size_t hstep = (size_t)HALF * K * 2;
    const size_t tstep = 2 * hstep;
    const unsigned ldsw = (unsigned)wid * 1024u;
    const int aoff = lds_byte(wr * 64 + fr, fq * 8), boff = lds_byte(wc * 32 + fr, fq * 8);
#define PG8_SA(b, h) (((b) * 2 + (h)) * HTB)
#define PG8_SB(b, h) ((4 + (b) * 2 + (h)) * HTB)
#define PG8_STAGE(bufoff, gbase, voff) do { _Pragma("unroll") for (int _i = 0; _i < 2; ++_i) \
        __builtin_amdgcn_global_load_lds((const unsigned*)((const char*)(gbase) + (voff)[_i]), (PG8_LAS unsigned*)(lds + (bufoff) + ldsw + _i * 8192), 16, 0, 0); } while (0)
#define PG8_LDA(dst, b, h) do { _Pragma("unroll") for (int m = 0; m < 4; ++m) _Pragma("unroll") for (int k = 0; k < 2; ++k) dst[m][k] = *(const PG8_LAS bf16x8*)(lds + PG8_SA(b, h) + aoff + m * 2048 + k * 1024); } while (0)
#define PG8_LDB(dst, b, h) do { _Pragma("unroll") for (int n = 0; n < 2; ++n) _Pragma("unroll") for (int k = 0; k < 2; ++k) dst[n][k] = *(const PG8_LAS bf16x8*)(lds + PG8_SB(b, h) + boff + n * 2048 + k * 1024); } while (0)
#define PG8_MMA(ai, bj, At, Bt) do { __builtin_amdgcn_s_setprio(1); _Pragma("unroll") for (int m = 0; m < 4; ++m) _Pragma("unroll") for (int n = 0; n < 2; ++n) _Pragma("unroll") for (int k = 0; k < 2; ++k) \
        acc[ai][bj][m][n] = __builtin_amdgcn_mfma_f32_16x16x32_bf16(Bt[n][k], At[m][k], acc[ai][bj][m][n], 0, 0, 0); __builtin_amdgcn_s_setprio(0); } while (0)
#define PG8_WAIT_V(n) asm volatile("s_waitcnt vmcnt(" #n ")" ::: "memory")
#define PG8_WAIT_L(n) asm volatile("s_waitcnt lgkmcnt(" #n ")" ::: "memory")
#define PG8_BAR __builtin_amdgcn_s_barrier()
#define PG8_SCHED __builtin_amdgcn_sched_barrier(0)
    Unit cur, nxt; int ui = 0;
    if (!S.next(0, cur)) return;
    f32x4 acc[2][2][4][2];
#pragma unroll
    for (int a = 0; a < 2; ++a)
#pragma unroll
        for (int b = 0; b < 2; ++b)
#pragma unroll
            for (int m = 0; m < 4; ++m)
#pragma unroll
                for (int n = 0; n < 2; ++n) acc[a][b][m][n] = (f32x4){0.f, 0.f, 0.f, 0.f};
    bf16x8 At[4][2], B0[2][2], B1[2][2];
    const char* cA = (const char*)g.A + (size_t)cur.pm * tstep + (size_t)cur.kz * kzb; const char* cB = (const char*)g.Bt + (size_t)cur.pn * tstep + (size_t)cur.kz * kzb;
    S.a_ready(cur);
    if constexpr (SP2) {
        PG8_STAGE(PG8_SB(0, 0), cB, voffB); PG8_STAGE(PG8_SB(0, 1), cB + hstep, voffB); PG8_STAGE(PG8_SA(0, 0), cA, voffA); PG8_STAGE(PG8_SA(0, 1), cA + hstep, voffA);
        if (wr == 1) PG8_BAR;
        PG8_WAIT_V(2); PG8_BAR;
        PG8_STAGE(PG8_SB(1, 0), cB + kstep, voffB); PG8_STAGE(PG8_SA(1, 0), cA + kstep, voffA); PG8_STAGE(PG8_SB(1, 1), cB + hstep + kstep, voffB);
        PG8_WAIT_V(6); PG8_BAR;
    } else {
        PG8_STAGE(PG8_SB(0, 0), cB, voffB); PG8_STAGE(PG8_SA(0, 0), cA, voffA); PG8_STAGE(PG8_SB(0, 1), cB + hstep, voffB); PG8_STAGE(PG8_SA(0, 1), cA + hstep, voffA);
        if (wr == 1) PG8_BAR;
        PG8_WAIT_V(4); PG8_BAR;
        PG8_STAGE(PG8_SB(1, 0), cB + kstep, voffB); PG8_STAGE(PG8_SA(1, 0), cA + kstep, voffA); PG8_STAGE(PG8_SB(1, 1), cB + hstep + kstep, voffB);
        PG8_WAIT_V(6); PG8_BAR;
    }
    for (;;) {
        const bool has_next = S.next(ui + 1, nxt);
        const char* nA = has_next ? (const char*)g.A + (size_t)nxt.pm * tstep + (size_t)nxt.kz * kzb : cA; const char* nB = has_next ? (const char*)g.Bt + (size_t)nxt.pn * tstep + (size_t)nxt.kz * kzb : cB;
        for (int t = 0; t < nt; t += 2) {
            const bool last = (t == nt - 2);
            const char* a1 = cA + (size_t)(t + 1) * kstep;
            const char* a2 = last ? nA : cA + (size_t)(t + 2) * kstep; const char* b2 = last ? nB : cB + (size_t)(t + 2) * kstep;
            const char* a3 = a2 + kstep; const char* b3 = b2 + kstep;
            if (last && has_next) S.a_ready(nxt);
            if constexpr (SP2) {
            PG8_LDB(B0, 0, 0); PG8_LDB(B1, 0, 1); PG8_SCHED; PG8_LDA(At, 0, 0); PG8_STAGE(PG8_SA(1, 1), a1 + hstep, voffA);
            PG8_WAIT_V(8); PG8_WAIT_L(0); PG8_BAR; PG8_MMA(0, 0, At, B0); PG8_MMA(0, 1, At, B1); PG8_BAR; PG8_SCHED;
            PG8_LDA(At, 0, 1); PG8_STAGE(PG8_SB(0, 0), b2, voffB); PG8_STAGE(PG8_SB(0, 1), b2 + hstep, voffB); PG8_STAGE(PG8_SA(0, 0), a2, voffA);
            PG8_WAIT_V(8); PG8_WAIT_L(0); PG8_BAR; PG8_MMA(1, 0, At, B0); PG8_MMA(1, 1, At, B1); PG8_BAR; PG8_SCHED;
            PG8_LDB(B0, 1, 0); PG8_LDB(B1, 1, 1); PG8_SCHED; PG8_LDA(At, 1, 0); PG8_STAGE(PG8_SA(0, 1), a2 + hstep, voffA);
            PG8_WAIT_V(8); PG8_WAIT_L(0); PG8_BAR; PG8_MMA(0, 0, At, B0); PG8_MMA(0, 1, At, B1); PG8_BAR; PG8_SCHED;
            PG8_LDA(At, 1, 1); PG8_STAGE(PG8_SB(1, 0), b3, voffB); PG8_STAGE(PG8_SB(1, 1), b3 + hstep, voffB); PG8_STAGE(PG8_SA(1, 0), a3, voffA);
            PG8_WAIT_V(8); PG8_WAIT_L(0); PG8_BAR; PG8_MMA(1, 0, At, B0); PG8_MMA(1, 1, At, B1); PG8_BAR; PG8_SCHED;
            } else {
            PG8_LDB(B0, 0, 0); PG8_SCHED; PG8_LDA(At, 0, 0); PG8_STAGE(PG8_SA(1, 1), a1 + hstep, voffA);
            PG8_WAIT_L(8); PG8_BAR; PG8_WAIT_L(0); PG8_MMA(0, 0, At, B0); PG8_BAR; PG8_SCHED;
            PG8_LDB(B1, 0, 1); PG8_STAGE(PG8_SB(0, 0), b2, voffB);
            PG8_BAR; PG8_WAIT_L(0); PG8_MMA(0, 1, At, B1); PG8_BAR;
            PG8_LDA(At, 0, 1); PG8_STAGE(PG8_SA(0, 0), a2, voffA);
            PG8_BAR; PG8_WAIT_L(0); PG8_MMA(1, 0, At, B0); PG8_BAR; PG8_SCHED;
            PG8_STAGE(PG8_SB(0, 1), b2 + hstep, voffB);
            PG8_WAIT_V(6); PG8_BAR; PG8_MMA(1, 1, At, B1); PG8_BAR;
            PG8_LDB(B0, 1, 0); PG8_SCHED; PG8_LDA(At, 1, 0); PG8_STAGE(PG8_SA(0, 1), a2 + hstep, voffA);
            PG8_WAIT_L(8); PG8_BAR; PG8_WAIT_L(0); PG8_MMA(0, 0, At, B0); PG8_BAR; PG8_SCHED;
            PG8_LDB(B1, 1, 1); PG8_STAGE(PG8_SB(1, 0), b3, voffB);
            PG8_BAR; PG8_WAIT_L(0); PG8_MMA(0, 1, At, B1); PG8_BAR;
            PG8_LDA(At, 1, 1); PG8_STAGE(PG8_SA(1, 0), a3, voffA);
            PG8_BAR; PG8_WAIT_L(0); PG8_MMA(1, 0, At, B0); PG8_BAR; PG8_SCHED;
            PG8_STAGE(PG8_SB(1, 1), b3 + hstep, voffB);
            PG8_WAIT_V(6); PG8_BAR; PG8_MMA(1, 1, At, B1); PG8_BAR;
            }
        }
        if constexpr (ALIGN_EPI) { if (wr == 0) PG8_BAR; }
        if constexpr (!Epi::AFTER_DRAIN) { E(acc, cur, wr, wc, fr, fq); S.done(cur); }
        if (!has_next) break;
#pragma unroll
        for (int a = 0; a < 2; ++a)
#pragma unroll
            for (int b = 0; b < 2; ++b)
#pragma unroll
                for (int m = 0; m < 4; ++m)
#pragma unroll
                    for (int n = 0; n < 2; ++n) acc[a][b][m][n] = (f32x4){0.f, 0.f, 0.f, 0.f};
        cur = nxt; cA = nA; cB = nB; ++ui;
        if constexpr (ALIGN_EPI) { if (wr == 1) PG8_BAR; }
    }
    PG8_WAIT_V(0);
    if constexpr (!ALIGN_EPI) { if (wr == 0) PG8_BAR; }
    PG8_BAR;
    if constexpr (Epi::AFTER_DRAIN) { E.fused(acc, cur, wr, wc, fr, fq, lds, wid, lane); S.done(cur); }
#undef PG8_SA
#undef PG8_SB
#undef PG8_STAGE
#undef PG8_LDA
#undef PG8_LDB
#undef PG8_MMA
#undef PG8_WAIT_V
#undef PG8_WAIT_L
#undef PG8_BAR
#undef PG8_SCHED
}
}
#include <hip/hip_bf16.h>
#include <cmath>
namespace attn_body {
using bf16=__hip_bfloat16;
using bf16x8=__attribute__((ext_vector_type(8)))short;
using s16x4=__attribute__((ext_vector_type(4)))short;
using f32x16=__attribute__((ext_vector_type(16)))float;
using u32x4=__attribute__((ext_vector_type(4)))unsigned;
constexpr int NHEAD=16,D=64,QP=1024,KP=256;
constexpr int NW=8,QBLK=32,QB=QBLK*NW,KVBLK=64;
constexpr int ATTN_UNIT_ROWS=QB;
__device__ __forceinline__ int crow(int r,int hi){return (r&3)+8*(r>>2)+4*hi;}
#define SBAR() __builtin_amdgcn_sched_barrier(0)
__device__ __forceinline__ void cmask(f32x16&p0,f32x16&p1,int jb,int qrel,int hi){
  const float NEG=-INFINITY; int kb=64*jb+4*hi;
  #pragma unroll
  for(int r=0;r<16;++r){int kv=kb+(r&3)+8*(r>>2); if(kv>qrel)p0[r]=NEG; if(kv+32>qrel)p1[r]=NEG;}
}

constexpr int NSLOT=3, SLOTB=8192;
constexpr int LDS_K=0, LDS_V=NSLOT*SLOTB, LDS_WS=2*NSLOT*SLOTB, LDS_OST=LDS_WS+NW*64*4, LDS_BYTES=LDS_OST+NW*4096;
constexpr float C2=0.125f*1.4426950408889634f;
__device__ __forceinline__ void glds16(const void*gsrc,unsigned lds_dst){unsigned keep;
  asm volatile("s_mov_b32 %0, m0\n\ts_mov_b32 m0, %2\n\ts_nop 0\n\tglobal_load_lds_dwordx4 %1, off\n\ts_mov_b32 m0, %0":"=&s"(keep):"v"(gsrc),"s"(lds_dst):"memory");}
__device__ __forceinline__ float max3f(float a,float b,float c){float r;asm("v_max3_f32 %0, %1, %2, %3":"=v"(r):"v"(a),"v"(b),"v"(c));return r;}
__device__ __forceinline__ float max2f(float a,float b){float r;asm("v_max_f32_e32 %0, %1, %2":"=v"(r):"v"(a),"v"(b));return r;}
__device__ __forceinline__ float fadd_s(float a,float b){float r;asm("v_add_f32_e32 %0, %1, %2":"=v"(r):"v"(a),"v"(b));return r;}
__device__ __forceinline__ float fsub_s(float a,float b){float r;asm("v_sub_f32_e32 %0, %1, %2":"=v"(r):"v"(a),"v"(b));return r;}
typedef float f32x2_t __attribute__((ext_vector_type(2))); typedef __bf16 bf16x2_t __attribute__((ext_vector_type(2)));
__device__ __forceinline__ unsigned cvtpk_s(float lo,float hi){f32x2_t v={lo,hi};bf16x2_t b=__builtin_convertvector(v,bf16x2_t);return __builtin_bit_cast(unsigned,b);}
#define WAIT_BAR(N) asm volatile("s_waitcnt vmcnt(" #N ") lgkmcnt(0)\n\ts_barrier":::"memory")

__device__ __forceinline__ void qkt(f32x16&p0,f32x16&p1,const char*Kslot,const bf16x8*qr,const f32x16&negm,int r32,int hi){
  const char*kb=Kslot+hi*1024+r32*16;
  #pragma unroll
  for(int d0=0;d0<4;++d0){
    const bf16x8 b0=*reinterpret_cast<const bf16x8*>(kb+d0*2048);
    const bf16x8 b1=*reinterpret_cast<const bf16x8*>(kb+d0*2048+512);
    if(d0==0){p0=__builtin_amdgcn_mfma_f32_32x32x16_bf16(b0,qr[0],negm,0,0,0);p1=__builtin_amdgcn_mfma_f32_32x32x16_bf16(b1,qr[0],negm,0,0,0);}
    else{p0=__builtin_amdgcn_mfma_f32_32x32x16_bf16(b0,qr[d0],p0,0,0,0);p1=__builtin_amdgcn_mfma_f32_32x32x16_bf16(b1,qr[d0],p1,0,0,0);}}
}
typedef __attribute__((address_space(3))) const char* lds_cptr;
typedef short v4i16_t __attribute__((ext_vector_type(4)));
__device__ __forceinline__ void kload8(bf16x8*kf,lds_cptr kp){
  kf[0]=*(const __attribute__((address_space(3))) bf16x8*)(kp);      kf[1]=*(const __attribute__((address_space(3))) bf16x8*)(kp+512);
  kf[2]=*(const __attribute__((address_space(3))) bf16x8*)(kp+2048); kf[3]=*(const __attribute__((address_space(3))) bf16x8*)(kp+2560);
  kf[4]=*(const __attribute__((address_space(3))) bf16x8*)(kp+4096); kf[5]=*(const __attribute__((address_space(3))) bf16x8*)(kp+4608);
  kf[6]=*(const __attribute__((address_space(3))) bf16x8*)(kp+6144); kf[7]=*(const __attribute__((address_space(3))) bf16x8*)(kp+6656);
}
__device__ __forceinline__ void kload2(bf16x8*kf,lds_cptr kp,int j){ kf[2*j]=*(const __attribute__((address_space(3))) bf16x8*)(kp+j*2048); kf[2*j+1]=*(const __attribute__((address_space(3))) bf16x8*)(kp+j*2048+512); }
__device__ __forceinline__ s16x4 vtr(lds_cptr p){ return __builtin_bit_cast(s16x4,__builtin_amdgcn_ds_read_tr16_b64_v4i16((__attribute__((address_space(3))) v4i16_t*)p)); }
__device__ __forceinline__ float rowmax(const f32x16&p0,const f32x16&p1){
  float a=max3f(p0[0],p0[1],p1[0]),b=max3f(p0[2],p0[3],p1[1]);a=max3f(a,p1[2],p1[3]);
  #pragma unroll
  for(int r=4;r<16;r+=4){a=max3f(a,p0[r],p0[r+1]);b=max3f(b,p0[r+2],p0[r+3]);a=max3f(a,p1[r],p1[r+1]);b=max3f(b,p1[r+2],p1[r+3]);}
  const float m=max2f(a,b);
  auto rr=__builtin_amdgcn_permlane32_swap(__float_as_uint(m),__float_as_uint(m),false,false);
  return max2f(__uint_as_float(rr[0]),__uint_as_float(rr[1]));
}
__device__ __forceinline__ void pv(f32x16*o,int vb,bf16x8 pa0,bf16x8 pa1,bf16x8 pa2,bf16x8 pa3){
  #pragma unroll
  for(int d0=0;d0<2;++d0){s16x4 lo[4],hi[4];
    #pragma unroll
    for(int ks=0;ks<4;++ks){
      asm volatile("ds_read_b64_tr_b16 %0,%1 offset:%c2":"=&v"(lo[ks]):"v"(vb),"i"(d0*4096+ks*1024):"memory");
      asm volatile("ds_read_b64_tr_b16 %0,%1 offset:%c2":"=&v"(hi[ks]):"v"(vb),"i"(d0*4096+ks*1024+512):"memory");}
    asm volatile("s_waitcnt lgkmcnt(0)":::"memory");SBAR();
    #define PK(k) (bf16x8){lo[k][0],lo[k][1],lo[k][2],lo[k][3],hi[k][0],hi[k][1],hi[k][2],hi[k][3]}
    o[d0]=__builtin_amdgcn_mfma_f32_32x32x16_bf16(pa0,PK(0),o[d0],0,0,0);
    o[d0]=__builtin_amdgcn_mfma_f32_32x32x16_bf16(pa1,PK(1),o[d0],0,0,0);
    o[d0]=__builtin_amdgcn_mfma_f32_32x32x16_bf16(pa2,PK(2),o[d0],0,0,0);
    o[d0]=__builtin_amdgcn_mfma_f32_32x32x16_bf16(pa3,PK(3),o[d0],0,0,0);
    #undef PK
  }
}

#ifndef ATTN_STORE16
#define ATTN_STORE16(p,v) (*(u32x4*)(p)=(v))
#endif
template<int THRL> __device__ __forceinline__ void attn_unit(int qrow0,int h,int NT,const bf16*Q,const bf16*__restrict__ K,const bf16*__restrict__ V,bf16*O,char*shm){
  const int tid=TIDX(),lane=tid&63,r32=lane&31,hi=lane>>5; const int wid=__builtin_amdgcn_readfirstlane(tid>>6);
  const bf16*Qw=Q+(long)(qrow0+wid*QBLK)*QP+h*D;
  const bf16*Kh=K+(h>>2)*D,*Vh=V+(h>>2)*D;
  const unsigned lds0=(unsigned)(uintptr_t)shm;
  float*wsf=(float*)(shm+LDS_WS)+wid*64;
  const bf16*ksrc=Kh+(long)lane*KP+wid*8;
  const bf16*vsrc=Vh+(long)(16*(wid&3)+(lane>>2))*KP+(wid>>2)*32+(lane&3)*8;
  const unsigned kdst=lds0+LDS_K+wid*1024, vdst=lds0+LDS_V+wid*1024;
  #define DMA_K(t,slot) glds16(ksrc+(long)(t)*KVBLK*KP,(unsigned)__builtin_amdgcn_readfirstlane(kdst+(slot)))
  #define DMA_V(t,slot) glds16(vsrc+(long)(t)*KVBLK*KP,(unsigned)__builtin_amdgcn_readfirstlane(vdst+(slot)))
  const int vb0=(int)(lds0+LDS_V)+((lane>>4)&1)*32+(lane&3)*8+(4*hi+((lane&15)>>2))*64;
  const char*Kbase=shm+LDS_K; bf16x8 kf[8];
  const lds_cptr shm3=(lds_cptr)shm; const lds_cptr kp0=shm3+LDS_K+hi*1024+r32*16; const lds_cptr vp0=shm3+LDS_V+((lane>>4)&1)*32+(lane&3)*8+(4*hi+((lane&15)>>2))*64;
  DMA_K(0,0);DMA_V(0,0);DMA_K(1,SLOTB);
  bf16x8 qr[4];
  #pragma unroll
  for(int d0=0;d0<4;++d0)qr[d0]=*reinterpret_cast<const bf16x8*>(&Qw[(long)r32*QP+d0*16+hi*8]);
  float mhat=0.f,l_reg=0.f;f32x16 o[2];o[0]=f32x16{};o[1]=f32x16{};f32x16 negm=f32x16{};asm volatile("":"+v"(negm));
  #define CMASK(P0,P1,t) do{}while(0)
  bool resc=false;
  #define START(P0,P1) do{ const float rm=rowmax(P0,P1); resc=false; \
    { const float dl=rm; mhat=fadd_s(mhat,dl); \
      _Pragma("unroll") for(int r=0;r<16;++r){P0[r]=fsub_s(P0[r],dl);P1[r]=fsub_s(P1[r],dl);} \
      _Pragma("unroll") for(int r=0;r<16;++r)negm[r]=-mhat; asm volatile("":"+v"(negm)); } \
    _Pragma("unroll") for(int r=0;r<16;++r)P0[r]=__builtin_amdgcn_exp2f(P0[r]); }while(0)
  #define RESC() do{ if(resc){ asm volatile("s_waitcnt lgkmcnt(0)":::"memory"); \
      _Pragma("unroll") for(int d_=0;d_<2;++d_) _Pragma("unroll") for(int r=0;r<16;++r)o[d_][r]*=wsf[crow(r,hi)]; } }while(0)
  f32x16 pA0,pA1,pB0,pB1;
  int sl_prev=0,sl_cur=0,sl_next=SLOTB;
  #define ROT() do{sl_prev=sl_cur;sl_cur=sl_next;sl_next=(sl_next==(NSLOT-1)*SLOTB)?0:sl_next+SLOTB;}while(0)
  DMA_K(2,2*SLOTB);
  WAIT_BAR(3);
  qkt(pA0,pA1,Kbase,qr,negm,r32,hi);asm volatile("s_nop 15\n\ts_nop 7":"+v"(pA0),"+v"(pA1));CMASK(pA0,pA1,0);
  START(pA0,pA1);
  _Pragma("unroll") for(int r=0;r<16;++r)pA1[r]=__builtin_amdgcn_exp2f(pA1[r]);
  WAIT_BAR(0);
  DMA_K(3,0);DMA_V(1,SLOTB);
  ROT();
  kload8(kf,kp0+sl_cur);
  WAIT_BAR(2);
  s16x4 vlo[8],vhi[8]; u32x4 pw0,pw1,pw2,pw3;
  #define PKW(P,B) cvtpk_s(P[B],P[B+1])
  #define PAF(k) __builtin_bit_cast(bf16x8,pw##k)
  #define VFR(i) (bf16x8){vlo[i][0],vlo[i][1],vlo[i][2],vlo[i][3],vhi[i][0],vhi[i][1],vhi[i][2],vhi[i][3]}
  #define PIN(x) asm volatile("":"+v"(x))
  #define MX3(a,b,c) __builtin_fmaxf(__builtin_fmaxf((a),(b)),(c))
  #define GAPA(MF,A0,A1,A2,A3,W0,W1,PW) do{ MF; sacc+=A0; sacc+=A1; sacc+=A2; sacc+=A3; PIN(sacc); W0; W1; PIN(PW); SBAR(); }while(0)
  #define EX(v) __builtin_amdgcn_exp2f(v)
  #define GAPB(MF,X,B) do{ MF; X[B]=EX(X[B]); X[B+1]=EX(X[B+1]); X[B+2]=EX(X[B+2]); X[B+3]=EX(X[B+3]); PIN(X); SBAR(); }while(0)
  #define VRD(i) do{ vlo[i]=vtr(vp_+(((i)>>2)*4096+((i)&3)*1024)); vhi[i]=vtr(vp_+(((i)>>2)*4096+((i)&3)*1024+512)); }while(0)
  #define KRD(G,j) do{ if(G){ kload2(kf,kp0+sl_next,j); SBAR(); } }while(0)
  #define STEP(C0,C1,P0,P1,t,GK,GV,GL) do{ SBAR(); \
    const lds_cptr vp_=vp0+sl_prev; \
    VRD(0); SBAR(); float sacc=(P0[0]+P0[1]); \
    GAPA(C0=__builtin_amdgcn_mfma_f32_32x32x16_bf16(kf[0],qr[0],negm,0,0,0), P0[2],P0[3],P0[4],P0[5],     pw0[0]=PKW(P0,0), pw0[1]=PKW(P0,2), pw0); \
    VRD(4); SBAR(); GAPA(C1=__builtin_amdgcn_mfma_f32_32x32x16_bf16(kf[1],qr[0],negm,0,0,0), P0[6],P0[7],P0[8],P0[9],     pw0[2]=PKW(P0,4), pw0[3]=PKW(P0,6), pw0); \
    VRD(1); SBAR(); GAPA(C0=__builtin_amdgcn_mfma_f32_32x32x16_bf16(kf[2],qr[1],C0,0,0,0),   P0[10],P0[11],P0[12],P0[13], pw1[0]=PKW(P0,8), pw1[1]=PKW(P0,10), pw1); \
    VRD(5); SBAR(); GAPA(C1=__builtin_amdgcn_mfma_f32_32x32x16_bf16(kf[3],qr[1],C1,0,0,0),   P0[14],P0[15],P1[0],P1[1],   pw1[2]=PKW(P0,12),pw1[3]=PKW(P0,14), pw1); \
    VRD(2); SBAR(); GAPA(C0=__builtin_amdgcn_mfma_f32_32x32x16_bf16(kf[4],qr[2],C0,0,0,0),   P1[2],P1[3],P1[4],P1[5],     pw2[0]=PKW(P1,0), pw2[1]=PKW(P1,2), pw2); \
    VRD(6); SBAR(); GAPA(C1=__builtin_amdgcn_mfma_f32_32x32x16_bf16(kf[5],qr[2],C1,0,0,0),   P1[6],P1[7],P1[8],P1[9],     pw2[2]=PKW(P1,4), pw2[3]=PKW(P1,6), pw2); \
    VRD(3); SBAR(); GAPA(C0=__builtin_amdgcn_mfma_f32_32x32x16_bf16(kf[6],qr[3],C0,0,0,0),   P1[10],P1[11],P1[12],P1[13], pw3[0]=PKW(P1,8), pw3[1]=PKW(P1,10), pw3); \
    VRD(7); SBAR(); GAPA(C1=__builtin_amdgcn_mfma_f32_32x32x16_bf16(kf[7],qr[3],C1,0,0,0),   P1[14],P1[15],0.f,0.f,       pw3[2]=PKW(P1,12),pw3[3]=PKW(P1,14), pw3); \
    l_reg+=sacc; \
    if(GK){DMA_K((t)+3,sl_cur);} if(GV){DMA_V((t)+1,sl_next);} \
    CMASK(C0,C1,t); \
    { float a=MX3(C0[0],C0[1],C1[0]),b=MX3(C0[2],C0[3],C1[1]); a=MX3(a,C1[2],C1[3]); \
      _Pragma("unroll") for(int r=4;r<16;r+=4){a=MX3(a,C0[r],C0[r+1]);b=MX3(b,C0[r+2],C0[r+3]);a=MX3(a,C1[r],C1[r+1]);b=MX3(b,C1[r+2],C1[r+3]);} \
      float rm=__builtin_fmaxf(a,b); { auto rr=__builtin_amdgcn_permlane32_swap(__float_as_uint(rm),__float_as_uint(rm),false,false); rm=__builtin_fmaxf(__uint_as_float(rr[0]),__uint_as_float(rr[1])); } \
      resc=false; \
      if(__builtin_expect(__any(rm>(float)THRL),0)){ const float dl=__builtin_fmaxf(rm,0.f); mhat+=dl; \
        _Pragma("unroll") for(int r=0;r<16;++r){C0[r]-=dl;C1[r]-=dl;} \
        _Pragma("unroll") for(int r=0;r<16;++r)negm[r]=-mhat; asm volatile("":"+v"(negm)); \
        const float f=__builtin_amdgcn_exp2f(-dl); l_reg*=f; if(hi==0)wsf[r32]=f; resc=true; } } \
    SBAR(); \
    GAPB(o[0]=__builtin_amdgcn_mfma_f32_32x32x16_bf16(PAF(0),VFR(0),o[0],0,0,0), C0,0); \
    GAPB(o[1]=__builtin_amdgcn_mfma_f32_32x32x16_bf16(PAF(0),VFR(4),o[1],0,0,0), C0,4); \
    KRD(GL,0); GAPB(o[0]=__builtin_amdgcn_mfma_f32_32x32x16_bf16(PAF(1),VFR(1),o[0],0,0,0), C0,8); \
    KRD(GL,1); GAPB(o[1]=__builtin_amdgcn_mfma_f32_32x32x16_bf16(PAF(1),VFR(5),o[1],0,0,0), C0,12); \
    KRD(GL,2); GAPB(o[0]=__builtin_amdgcn_mfma_f32_32x32x16_bf16(PAF(2),VFR(2),o[0],0,0,0), C1,0); \
    KRD(GL,3); GAPB(o[1]=__builtin_amdgcn_mfma_f32_32x32x16_bf16(PAF(2),VFR(6),o[1],0,0,0), C1,4); \
    GAPB(o[0]=__builtin_amdgcn_mfma_f32_32x32x16_bf16(PAF(3),VFR(3),o[0],0,0,0), C1,8); \
    GAPB(o[1]=__builtin_amdgcn_mfma_f32_32x32x16_bf16(PAF(3),VFR(7),o[1],0,0,0), C1,12); \
    }while(0)
  int t=1;
  #undef CMASK
  #define CMASK(P0,P1,t) do{}while(0)
  for(;t+5<NT;t+=2){
    STEP(pB0,pB1,pA0,pA1,t,true,true,true);     WAIT_BAR(2); RESC(); ROT();
    STEP(pA0,pA1,pB0,pB1,t+1,true,true,true);   WAIT_BAR(2); RESC(); ROT();
  }
  #undef CMASK
  #define CMASK(P0,P1,t) do{}while(0)
  #define ENDW(tt) do{ if((tt)+3<NT){WAIT_BAR(2);} else if((tt)+2<NT){WAIT_BAR(1);} else {WAIT_BAR(0);} }while(0)
  for(;t+1<NT;t+=2){
    STEP(pB0,pB1,pA0,pA1,t,(t+3<NT),(t+1<NT),(t+1<NT));       ENDW(t);   RESC(); ROT();
    STEP(pA0,pA1,pB0,pB1,t+1,(t+4<NT),(t+2<NT),(t+2<NT));     ENDW(t+1); RESC(); ROT();
  }
  STEP(pB0,pB1,pA0,pA1,NT-1,false,false,false); RESC();
  { float sacc=pB0[0]+pB0[1]; _Pragma("unroll") for(int r=2;r<16;++r)sacc+=pB0[r]; _Pragma("unroll") for(int r=0;r<16;++r)sacc+=pB1[r]; l_reg+=sacc;
    pw0=(u32x4){PKW(pB0,0),PKW(pB0,2),PKW(pB0,4),PKW(pB0,6)};pw1=(u32x4){PKW(pB0,8),PKW(pB0,10),PKW(pB0,12),PKW(pB0,14)};pw2=(u32x4){PKW(pB1,0),PKW(pB1,2),PKW(pB1,4),PKW(pB1,6)};pw3=(u32x4){PKW(pB1,8),PKW(pB1,10),PKW(pB1,12),PKW(pB1,14)};
    SBAR(); pv(o,vb0+sl_cur,PAF(0),PAF(1),PAF(2),PAF(3)); }
  #undef PKW
  #undef PAF
  #undef VFR
  #undef PIN
  #undef MX3
  #undef GAPA
  #undef GAPB
  #undef EX
  #undef VRD
  #undef KRD
  #undef STEP
  #undef ENDW
  {auto rr=__builtin_amdgcn_permlane32_swap(__float_as_uint(l_reg),__float_as_uint(l_reg),false,false);l_reg=__uint_as_float(rr[0])+__uint_as_float(rr[1]);}
  if(hi==0)wsf[32+r32]=l_reg;asm volatile("s_waitcnt lgkmcnt(0)":::"memory");
  float rli[16];
  #pragma unroll
  for(int r=0;r<16;++r)rli[r]=__builtin_amdgcn_rcpf(wsf[32+crow(r,hi)]);
  bf16*Ow=O+(long)(qrow0+wid*QBLK)*QP+h*D;
  { bf16*stg=(bf16*)(shm+LDS_OST)+wid*2048;
    #pragma unroll
    for(int r=0;r<16;++r){const int orow=crow(r,hi);
      #pragma unroll
      for(int d0=0;d0<2;++d0)stg[orow*64+d0*32+r32]=__float2bfloat16(o[d0][r]*rli[r]);}
    asm volatile("s_waitcnt lgkmcnt(0)":::"memory");
    #pragma unroll
    for(int i=0;i<4;++i){const int row=i*8+(lane>>3),ch=lane&7; const u32x4 v=*(const u32x4*)(stg+row*64+ch*8); ATTN_STORE16(Ow+(long)row*QP+ch*8,v);} }
  asm volatile("s_waitcnt lgkmcnt(0)\n\ts_barrier":::"memory");
  #undef DMA_K
  #undef DMA_V
  #undef CMASK
  #undef START
  #undef RESC
  #undef ROT
}
constexpr int ATTN_LDS_BYTES=LDS_BYTES;
#undef SBAR
#undef WAIT_BAR
}
#define LAS __attribute__((address_space(3)))
typedef unsigned short u16;
typedef unsigned U4 __attribute__((ext_vector_type(4)));
typedef unsigned U2 __attribute__((ext_vector_type(2)));
typedef float F4 __attribute__((ext_vector_type(4)));
typedef float F2 __attribute__((ext_vector_type(2)));
typedef short S8 __attribute__((ext_vector_type(8)));
typedef float F16v __attribute__((ext_vector_type(16)));

constexpr int NWAVES = 8, NTHR = 512;
constexpr int L = 16384, CTX = 256, M = L + CTX, D = 1024, FH = 2816;
constexpr float EPS = 1e-6f;
constexpr int LDS_BYTES = 147456;
constexpr size_t MiB = 1u << 20;
constexpr size_t WS_MOD = 64 * 1024, WS_STATS = 512 * 1024;
constexpr size_t SZ_FI = (size_t)5632 * 1024 * 2, SZ_FO = (size_t)1024 * 2816 * 2;
constexpr size_t W_L0 = 1 * MiB, W_FI0 = W_L0, W_FO0 = W_FI0 + SZ_FI, W_GMI = W_FO0 + SZ_FO, W_GMO = W_GMI + (size_t)4096 * 1024 * 2;
constexpr size_t W_L1 = W_GMO + (size_t)1024 * 2048 * 2, W_FI1 = W_L1, W_FO1 = W_FI1 + SZ_FI, W_QKV = W_FO1 + SZ_FO, W_ATO = W_QKV + (size_t)1536 * 1024 * 2;
constexpr size_t W_L2 = W_ATO + (size_t)1024 * 1024 * 2, W_FI2 = W_L2, W_FO2 = W_FI2 + SZ_FI, W_HYI = W_FO2 + SZ_FO, W_HYO = W_HYI + (size_t)3072 * 1024 * 2;
constexpr size_t W_L3 = W_HYO + (size_t)1024 * 1024 * 2, W_FI3 = W_L3, W_FO3 = W_FI3 + SZ_FI, W_SSI = W_FO3 + SZ_FO, W_SSO = W_SSI + (size_t)5376 * 1024 * 2;
constexpr size_t W_END = W_SSO + (size_t)1024 * 2048 * 2;
constexpr size_t WS_YF = 1 * MiB;
static_assert(WS_YF + 64 * MiB <= W_L3, "y_fwd overlay must not touch layer 3 weights");
constexpr size_t WS_X = 107 * MiB; static_assert(W_END <= WS_X, "weights");
constexpr size_t WS_H = 172 * MiB, WS_CB = WS_H, WS_BT = WS_H + (size_t)130 * 4 * 128 * 128 * 2;
constexpr size_t WS_BIG = 205 * MiB;
constexpr size_t B_U = WS_BIG, B_V = WS_BIG + 65 * MiB;
constexpr size_t B_ACT = WS_BIG;
constexpr size_t B_QKVR = WS_BIG, B_Q = WS_BIG + 49 * MiB, B_K = WS_BIG + 82 * MiB, B_VV = WS_BIG + 91 * MiB;
constexpr size_t B_P = WS_BIG, B_KK = WS_BIG, B_YT = WS_BIG + 64 * MiB, B_X0 = WS_BIG + 98 * MiB, B_UT = WS_BIG + 131 * MiB;
constexpr size_t B_Z = WS_BIG, B_XBC = WS_BIG + 65 * MiB, B_DT = WS_BIG + 163 * MiB;
constexpr size_t WS_ACS2 = 65 * MiB, WS_DTV = 70 * MiB;
static_assert(WS_DTV + (size_t)64 * M * 4 <= W_L3 && WS_YF + 64 * MiB <= WS_ACS2, "scan decay tables");
constexpr size_t WS_WV = WS_BIG + 168 * MiB, WS_TOT = WS_WV + 5 * MiB;
constexpr size_t WS_STATSP = WS_BIG + 131 * MiB;
constexpr size_t WS_PART = WS_BIG + 131 * MiB;
constexpr size_t WS_END = WS_BIG + 179 * MiB;
constexpr size_t OUT_KK = 0, OUT_HALO = 8 * MiB;
constexpr size_t WS_HID2 = WS_BIG + 174 * MiB;

typedef float f32x2_t __attribute__((ext_vector_type(2))); typedef __bf16 bf16x2_t __attribute__((ext_vector_type(2)));
__device__ __forceinline__ unsigned pk2(float lo, float hi) { const f32x2_t v = {lo, hi}; const bf16x2_t b = __builtin_convertvector(v, bf16x2_t); return __builtin_bit_cast(unsigned, b); }
__device__ __forceinline__ unsigned f2bf(float f) { return pk2(f, f) & 0xffffu; }
__device__ __forceinline__ float bflo(unsigned w) { return __uint_as_float(w << 16); }
__device__ __forceinline__ float bfhi(unsigned w) { return __uint_as_float(w & 0xffff0000u); }
__device__ __forceinline__ float bf1(u16 h) { return __uint_as_float((unsigned)h << 16); }
__device__ __forceinline__ float wave_sum(float v) {
#pragma unroll
    for (int o = 1; o < 64; o <<= 1) v += __shfl_xor(v, o);
    return v;
}
__device__ __forceinline__ void unpack8(const U4 w, float (&f)[8]) { f[0] = bflo(w.x); f[1] = bfhi(w.x); f[2] = bflo(w.y); f[3] = bfhi(w.y); f[4] = bflo(w.z); f[5] = bfhi(w.z); f[6] = bflo(w.w); f[7] = bfhi(w.w); }
__device__ __forceinline__ U4 pack8(const float (&f)[8]) { U4 w; w.x = pk2(f[0], f[1]); w.y = pk2(f[2], f[3]); w.z = pk2(f[4], f[5]); w.w = pk2(f[6], f[7]); return w; }
__device__ __forceinline__ float softplus_f(float x) { return x > 15.f ? x : log1pf(__expf(x)); }

#define LDS_BAR() asm volatile("s_waitcnt lgkmcnt(0)\n\ts_barrier" ::: "memory")
struct Args { const float* in[40]; float* out; unsigned char* ws; int ph_lo, ph_hi; };
enum { I_X = 0, I_C, I_CTX, I_CCTX, I_N1G, I_N2G, I_MODW, I_MODB, I_FFI, I_FFO, I_FING, I_GMWI, I_GMLG, I_GMLB, I_GMWS, I_GMBS, I_GMWO, I_ATQKV, I_ATQG, I_ATKG, I_ATWO,
       I_HYWI, I_HYCW, I_HYCB, I_HYW1, I_HYB1, I_HYW2, I_HYB2, I_HYW3, I_HYFR, I_HYSK, I_HYWO, I_SSWI, I_SSCW, I_SSCB, I_SSAL, I_SSDB, I_SSDS, I_SSNG, I_SSWO };

__device__ __forceinline__ void p0_transpose_item(const float* W, int K, int N, u16* WT, int mode, float* scr, int item, int lane) {
    const int nblk = N / 32, kb = item / nblk, nb = item % nblk, k0 = 64 * kb, n0 = 32 * nb;
#pragma unroll 8
    for (int i = 0; i < 32; ++i) { const int kk = 2 * i + (lane >> 5); scr[kk * 33 + (lane & 31)] = W[(size_t)(k0 + kk) * N + n0 + (lane & 31)]; }
    __builtin_amdgcn_wave_barrier(); asm volatile("s_waitcnt lgkmcnt(0)" ::: "memory");
    int rbase = n0;
    if (mode == 1) { if (n0 < 2816) rbase = 256 * (n0 >> 7) + (n0 & 127); else { const int n1 = n0 - 2816; rbase = 256 * (n1 >> 7) + 128 + (n1 & 127); } }
    const int c = lane & 7;
#pragma unroll
    for (int j = 0; j < 4; ++j) { const int n = (lane >> 3) + 8 * j; const float* s = scr + (8 * c) * 33 + n;
        U4 o; o.x = pk2(s[0 * 33], s[1 * 33]); o.y = pk2(s[2 * 33], s[3 * 33]); o.z = pk2(s[4 * 33], s[5 * 33]); o.w = pk2(s[6 * 33], s[7 * 33]);
        *(U4*)(WT + (size_t)(rbase + n) * K + k0 + 8 * c) = o; }
    asm volatile("s_waitcnt lgkmcnt(0)" ::: "memory"); __builtin_amdgcn_wave_barrier();
}

__device__ __forceinline__ void convert_layer(const Args& a, int ly, unsigned char* lds, int vb, int nb) {
    const int tid = TIDX(), lane = tid & 63, wave = __builtin_amdgcn_readfirstlane(tid >> 6);
    unsigned char* ws = a.ws;
    float* scr = (float*)(lds + wave * 16384);
    const int gw = vb * NWAVES + wave, NGW = nb * NWAVES;
    constexpr int T_FI = 16 * 176, T_FO = 44 * 32, T_GMI = 16 * 128, T_GMO = 32 * 32, T_QKV = 16 * 48, T_ATO = 16 * 32, T_HYI = 16 * 96, T_HYO = 16 * 32, T_SSI = 16 * 162, T_SSO = 32 * 32;
    const int t_in = ly == 0 ? T_GMI : ly == 1 ? T_QKV : ly == 2 ? T_HYI : T_SSI, t_out = ly == 0 ? T_GMO : ly == 1 ? T_ATO : ly == 2 ? T_HYO : T_SSO;
    const size_t o_fi = ly == 0 ? W_FI0 : ly == 1 ? W_FI1 : ly == 2 ? W_FI2 : W_FI3, o_fo = ly == 0 ? W_FO0 : ly == 1 ? W_FO1 : ly == 2 ? W_FO2 : W_FO3;
    const int nit = T_FI + T_FO + t_in + t_out;
    for (int it = gw; it < nit; it += NGW) {
        int r = it;
        if (r < T_FI) { p0_transpose_item(a.in[I_FFI] + (size_t)ly * 1024 * 5632, 1024, 5632, (u16*)(ws + o_fi), 1, scr, r, lane); continue; } r -= T_FI;
        if (r < T_FO) { p0_transpose_item(a.in[I_FFO] + (size_t)ly * 2816 * 1024, 2816, 1024, (u16*)(ws + o_fo), 0, scr, r, lane); continue; } r -= T_FO;
        if (r < t_in) {
            if (ly == 0) p0_transpose_item(a.in[I_GMWI], 1024, 4096, (u16*)(ws + W_GMI), 0, scr, r, lane);
            else if (ly == 1) p0_transpose_item(a.in[I_ATQKV], 1024, 1536, (u16*)(ws + W_QKV), 0, scr, r, lane);
            else if (ly == 2) p0_transpose_item(a.in[I_HYWI], 1024, 3072, (u16*)(ws + W_HYI), 0, scr, r, lane);
            else p0_transpose_item(a.in[I_SSWI], 1024, 5184, (u16*)(ws + W_SSI), 0, scr, r, lane);
            continue; } r -= t_in;
        if (ly == 0) p0_transpose_item(a.in[I_GMWO], 2048, 1024, (u16*)(ws + W_GMO), 0, scr, r, lane);
        else if (ly == 1) p0_transpose_item(a.in[I_ATWO], 1024, 1024, (u16*)(ws + W_ATO), 0, scr, r, lane);
        else if (ly == 2) p0_transpose_item(a.in[I_HYWO], 1024, 1024, (u16*)(ws + W_HYO), 0, scr, r, lane);
        else p0_transpose_item(a.in[I_SSWO], 2048, 1024, (u16*)(ws + W_SSO), 0, scr, r, lane);
    }
    if (ly == 3) {
        U4* z = (U4*)(ws + W_SSI + (size_t)5184 * 1024 * 2); const U4 zero = {0u, 0u, 0u, 0u};
        for (int i = vb * NTHR + tid; i < 192 * 1024 / 8; i += nb * NTHR) z[i] = zero; }
}

__device__ __forceinline__ void phase_prologue(const Args& a, unsigned char* lds, int bid, int G) {
    const int tid = TIDX(), lane = tid & 63, wave = __builtin_amdgcn_readfirstlane(tid >> 6);
    unsigned char* ws = a.ws;
    float* scr = (float*)(lds + wave * 16384);
    const int gw = bid * NWAVES + wave, NGW = G * NWAVES;
    convert_layer(a, 0, lds, bid, G);
    {
        float* HID2 = (float*)(ws + WS_HID2);
        const float* w1 = a.in[I_HYW1]; const float* w2 = a.in[I_HYW2];
        const float b1 = a.in[I_HYB1][lane], b2 = a.in[I_HYB2][lane], fr = a.in[I_HYFR][lane];
        for (int pos = gw; pos < M; pos += NGW) {
            const int idx = pos < CTX ? pos : pos - CTX; const float Lc = pos < CTX ? 256.f : 16384.f;
            float feat = 0.f;
            if (lane == 0) feat = (float)idx / (Lc - 1.f);
            else if (lane <= 32) { const int b = (lane - 1) & 15; const float f = 1e-4f + (float)b * ((15.f - 1e-4f) / 15.f); const float rev = ((float)idx / Lc) * f;
                feat = lane <= 16 ? __builtin_amdgcn_cosf(rev) : -__builtin_amdgcn_sinf(rev); }
            float acc = b1;
#pragma unroll 11
            for (int e = 0; e < 33; ++e) acc += __shfl(feat, e) * w1[e * 64 + lane];
            const float h1 = __sinf(fr * acc);
            float acc2 = b2;
#pragma unroll 16
            for (int e = 0; e < 64; ++e) acc2 += __shfl(h1, e) * w2[e * 64 + lane];
            HID2[(size_t)pos * 64 + lane] = __sinf(fr * acc2);
        }
    }
    {
        float* MOD = (float*)(ws + WS_MOD); float* red = (float*)lds;
        __syncthreads();
        for (int it = bid; it < 4 * 192; it += G) {
            const int ly = it / 192, cg = it % 192, n = cg * 32 + (lane & 31), kpar = lane >> 5;
            const float* Wm = a.in[I_MODW] + (size_t)ly * 1024 * 6144;
            float a0 = 0.f, a1 = 0.f;
#pragma unroll 8
            for (int k = wave * 128 + kpar; k < wave * 128 + 128; k += 2) { const float w = Wm[(size_t)k * 6144 + n]; a0 += silu_f(a.in[I_C][k]) * w; a1 += silu_f(a.in[I_CCTX][k]) * w; }
            a0 += __shfl_xor(a0, 32); a1 += __shfl_xor(a1, 32);
            if (lane < 32) { red[(wave * 2 + 0) * 32 + lane] = a0; red[(wave * 2 + 1) * 32 + lane] = a1; }
            __syncthreads();
            if (tid < 64) { const int which = tid >> 5, nn = cg * 32 + (tid & 31); float s = a.in[I_MODB][ly * 6144 + nn];
#pragma unroll
                for (int w = 0; w < 8; ++w) s += red[(w * 2 + which) * 32 + (tid & 31)];
                MOD[((size_t)ly * 2 + which) * 6144 + nn] = s; }
            __syncthreads();
        }
    }
}
__device__ __forceinline__ void phase_norm_mod(float* src_ctx, const float* src_lat, float* Xcopy, const float* gain, const float* modL, const float* modC, int sh_off, int sc_off,
                                               u16* H, int row_lo, const float* part, int nks, const float* pgate, int bid, int G) {
    const int lane = TIDX() & 63, wave = __builtin_amdgcn_readfirstlane(TIDX() >> 6);
    const int gw = bid * NWAVES + wave, NGW = G * NWAVES;
#pragma unroll 1
    for (int pass = (row_lo >= CTX ? 1 : 0); pass < 2; ++pass) {
        const float* mod = pass == 0 ? modC : modL;
        F4 ga[4], sh[4];
#pragma unroll
        for (int j = 0; j < 4; ++j) { ga[j] = ((const F4*)gain)[lane + 64 * j] * (((const F4*)(mod + sc_off))[lane + 64 * j] + 1.0f); sh[j] = ((const F4*)(mod + sh_off))[lane + 64 * j]; }
        const int rbeg = pass == 0 ? row_lo : (row_lo > CTX ? row_lo : CTX), rend = pass == 0 ? CTX : M;
        F4 vn[4];
        { const int r0 = rbeg + gw; if (r0 < rend) { const F4* xr = (const F4*)(r0 < CTX ? src_ctx + (size_t)r0 * D : src_lat + (size_t)(r0 - CTX) * D) + lane;
#pragma unroll
            for (int j = 0; j < 4; ++j) vn[j] = xr[64 * j]; } }
        for (int r = rbeg + gw; r < rend; r += NGW) {
            F4 v[4]; float s = 0.f;
#pragma unroll
            for (int j = 0; j < 4; ++j) v[j] = vn[j];
            { const int rn = r + NGW; if (rn < rend) { const F4* xr = (const F4*)(rn < CTX ? src_ctx + (size_t)rn * D : src_lat + (size_t)(rn - CTX) * D) + lane;
#pragma unroll
                for (int j = 0; j < 4; ++j) vn[j] = xr[64 * j]; } }
            if (part && r < CTX) {
#pragma unroll
                for (int j = 0; j < 4; ++j) { F4 ps = {0.f, 0.f, 0.f, 0.f}; for (int kz = 0; kz < nks; ++kz) ps += ((const F4*)(part + ((size_t)kz * 256 + r) * D))[lane + 64 * j];
                    v[j] += ((const F4*)pgate)[lane + 64 * j] * ps; ((F4*)(src_ctx + (size_t)r * D))[lane + 64 * j] = v[j]; }
            }
#pragma unroll
            for (int j = 0; j < 4; ++j) s += (v[j].x * v[j].x + v[j].y * v[j].y) + (v[j].z * v[j].z + v[j].w * v[j].w);
            const float rstd = rsqrtf(wave_sum(s) * (1.f / D) + EPS);
            if (Xcopy && r < CTX) { F4* xc = (F4*)(Xcopy + (size_t)r * D) + lane;
#pragma unroll
                for (int j = 0; j < 4; ++j) xc[64 * j] = v[j]; }
            U2* o8 = (U2*)(H + (size_t)r * D) + lane;
#pragma unroll
            for (int j = 0; j < 4; ++j) { const F4 y = v[j] * rstd * ga[j] + sh[j]; U2 w; w.x = pk2(y.x, y.y); w.y = pk2(y.z, y.w); o8[64 * j] = w; }
        }
    }
}
__device__ __forceinline__ void phase_ln_stats(const u16* V, float* STATS, int bid, int G) {
    const int lane = TIDX() & 63, wave = __builtin_amdgcn_readfirstlane(TIDX() >> 6);
    const int gw = bid * NWAVES + wave, NGW = G * NWAVES;
    for (int r = gw; r < M; r += NGW) {
        const U4* vr = (const U4*)(V + (size_t)r * 2048) + lane;
        float f[4][8]; float s = 0.f;
#pragma unroll
        for (int j = 0; j < 4; ++j) { unpack8(vr[64 * j], f[j]);
#pragma unroll
            for (int e = 0; e < 8; ++e) s += f[j][e]; }
        const float mean = wave_sum(s) * (1.f / 2048.f); float q = 0.f;
#pragma unroll
        for (int j = 0; j < 4; ++j)
#pragma unroll
            for (int e = 0; e < 8; ++e) { const float d = f[j][e] - mean; q += d * d; }
        const float rstd = rsqrtf(wave_sum(q) * (1.f / 2048.f) + EPS);
        if (lane == 0) { STATS[2 * r] = mean; STATS[2 * r + 1] = rstd; }
    }
}
__device__ __forceinline__ void phase_qk_rope(const u16* QKVR, const float* q_g, const float* k_g, u16* Qb, u16* Kb, u16* Vb, int bid, int G) {
    const int lane = TIDX() & 63, wave = __builtin_amdgcn_readfirstlane(TIDX() >> 6), l16 = lane & 15, hq = lane >> 4;
    const int gw = bid * NWAVES + wave, NGW = G * NWAVES;
    const int e0 = 4 * l16, i0 = e0 & 31;
    const F4 qg = *(const F4*)(q_g + e0), kg = *(const F4*)(k_g + e0);
    float inv[4];
#pragma unroll
    for (int j = 0; j < 4; ++j) inv[j] = exp2f(-(float)((i0 + j) & 15) * (13.287712379549449f / 16.f));
    constexpr float C2 = 0.125f * 1.4426950408889634f;
    for (int r = gw; r < M; r += NGW) {
        float cs[4] = {1.f, 1.f, 1.f, 1.f}, sn[4] = {0.f, 0.f, 0.f, 0.f};
        if (r >= CTX) { const int t = r - CTX; const float pos = i0 < 16 ? (float)(t >> 6) : (float)(t & 63);
#pragma unroll
            for (int j = 0; j < 4; ++j) { const float a = pos * inv[j]; cs[j] = __cosf(a); sn[j] = __sinf(a); } }
        const U2* row = (const U2*)(QKVR + (size_t)r * 1536);
#pragma unroll
        for (int i = 0; i < 6; ++i) {
            const U2 w = row[64 * i + lane]; const int hd = 4 * i + hq;
            if (i == 5) { ((U2*)(Vb + (size_t)r * 256))[(hd - 20) * 16 + l16] = w; continue; }
            float v[4] = {bflo(w.x), bfhi(w.x), bflo(w.y), bfhi(w.y)};
            float ss = (v[0] * v[0] + v[1] * v[1]) + (v[2] * v[2] + v[3] * v[3]);
#pragma unroll
            for (int o = 1; o < 16; o <<= 1) ss += __shfl_xor(ss, o);
            const float rs = rsqrtf(ss * (1.f / 64.f) + EPS);
            const bool isq = i < 4; const F4 gn = isq ? qg : kg;
            float y[4], p[4];
#pragma unroll
            for (int j = 0; j < 4; ++j) y[j] = v[j] * rs * gn[j];
#pragma unroll
            for (int j = 0; j < 4; ++j) p[j] = __shfl_xor(y[j], 8);
#pragma unroll
            for (int j = 0; j < 4; ++j) y[j] = l16 < 8 ? y[j] * cs[j] - p[j] * sn[j] : y[j] * cs[j] + p[j] * sn[j];
            U2 o2;
            if (isq) { o2.x = pk2(y[0] * C2, y[1] * C2); o2.y = pk2(y[2] * C2, y[3] * C2); ((U2*)(Qb + (size_t)r * 1024))[hd * 16 + l16] = o2; }
            else { o2.x = pk2(y[0], y[1]); o2.y = pk2(y[2], y[3]); ((U2*)(Kb + (size_t)r * 256))[(hd - 16) * 16 + l16] = o2; }
        }
    }
}
__device__ __forceinline__ void phase_ssd_finish(const u16* YF, const u16* YB, const u16* XBC, u16* Z, const float* d_skip, const float* norm_g, int bid, int G) {
    const int lane = TIDX() & 63, wave = __builtin_amdgcn_readfirstlane(TIDX() >> 6);
    const int gw = bid * NWAVES + wave, NGW = G * NWAVES;
    for (int t = gw; t < L; t += NGW) {
        const size_t R = (size_t)t + CTX;
#pragma unroll
        for (int j = 0; j < 4; ++j) {
            const int ch = 512 * j + 8 * lane;
            float yf[8], yb[8], xs[8], z[8], o[8];
            unpack8(*(const U4*)(YF + (size_t)t * 2048 + ch), yf); unpack8(*(const U4*)(YB + (size_t)t * 2048 + ch), yb);
            unpack8(*(const U4*)(XBC + R * 3072 + ch), xs); unpack8(*(const U4*)(Z + R * 2048 + ch), z);
            const float ds = d_skip[ch >> 6]; float ss = 0.f;
#pragma unroll
            for (int e = 0; e < 8; ++e) { const float y = yf[e] + yb[e] + xs[e] * ds; o[e] = y * silu_f(z[e]); ss += o[e] * o[e]; }
            const float rs = rsqrtf(wave_sum(ss) * (1.f / 512.f) + EPS);
            const F4 g0 = *(const F4*)(norm_g + ch), g1 = *(const F4*)(norm_g + ch + 4);
            o[0] *= rs * g0.x; o[1] *= rs * g0.y; o[2] *= rs * g0.z; o[3] *= rs * g0.w; o[4] *= rs * g1.x; o[5] *= rs * g1.y; o[6] *= rs * g1.z; o[7] *= rs * g1.w;
            *(U4*)(Z + R * 2048 + ch) = pack8(o);
        }
    }
}
__device__ __forceinline__ void phase_final(const float* X, const float* gain, float* out, int bid, int G) {
    const int lane = TIDX() & 63, wave = __builtin_amdgcn_readfirstlane(TIDX() >> 6);
    const int gw = bid * NWAVES + wave, NGW = G * NWAVES;
    F4 gn[4];
#pragma unroll
    for (int j = 0; j < 4; ++j) gn[j] = ((const F4*)gain)[lane + 64 * j];
    F4 vn[4];
    if (gw < L) { const F4* xr = (const F4*)(X + (size_t)(gw + CTX) * D) + lane;
#pragma unroll
        for (int j = 0; j < 4; ++j) vn[j] = xr[64 * j]; }
    for (int t = gw; t < L; t += NGW) {
        F4 v[4]; float s = 0.f;
#pragma unroll
        for (int j = 0; j < 4; ++j) { v[j] = vn[j]; s += (v[j].x * v[j].x + v[j].y * v[j].y) + (v[j].z * v[j].z + v[j].w * v[j].w); }
        if (t + NGW < L) { const F4* xr = (const F4*)(X + (size_t)(t + NGW + CTX) * D) + lane;
#pragma unroll
            for (int j = 0; j < 4; ++j) vn[j] = xr[64 * j]; }
        const float rstd = rsqrtf(wave_sum(s) * (1.f / D) + EPS);
        F4* o = (F4*)(out + (size_t)t * D) + lane;
#pragma unroll
        for (int j = 0; j < 4; ++j) o[64 * j] = v[j] * rstd * gn[j];
    }
}
__device__ __forceinline__ void phase_spatial(u16* U, const u16* V, const float* STATS, const float* gws, const float* gbs, const float* lng, const float* lnb, unsigned char* lds, int bid, int G) {
    const int tid = TIDX(), lane = tid & 63, wave = __builtin_amdgcn_readfirstlane(tid >> 6), il = lane & 15, quad = lane >> 4;
    u16* wsL = (u16*)lds;
    u16* vnT = (u16*)(lds + 128 * 136 * 2);
    float* rst = (float*)(lds + 128 * 136 * 2 + 256 * 136 * 2);
    for (int it = bid; it < 130 * 8; it += G) {
        const int n = it >> 3, g = it & 7;
        __syncthreads();
        if (tid < 128) { const F4* sp = (const F4*)(STATS + ((size_t)n * 128 + tid) * 64); float s1 = 0.f, s2 = 0.f;
#pragma unroll
            for (int i = 0; i < 16; ++i) { const F4 v = sp[i]; s1 += v.x + v.z; s2 += v.y + v.w; }
            const float mean = s1 * (1.f / 2048.f); rst[2 * tid] = mean; rst[2 * tid + 1] = rsqrtf(fmaxf(s2 * (1.f / 2048.f) - mean * mean, 0.f) + EPS); }
        __syncthreads();
#pragma unroll
        for (int i = 0; i < 8; ++i) { const int piece = tid + NTHR * i, p = piece >> 5, q4 = (piece & 31) * 4;
            const F4 w = *(const F4*)(gws + ((size_t)g * 128 + p) * 128 + q4); U2 o; o.x = pk2(w.x, w.y); o.y = pk2(w.z, w.w); *(U2*)(wsL + p * 136 + q4) = o; }
#pragma unroll
        for (int i = 0; i < 4; ++i) { const int cc = wave + 8 * i, l2 = lane;
            const size_t row = (size_t)n * 128 + 2 * l2; const int c0 = g * 256 + cc * 8;
            float f0[8], f1[8]; unpack8(*(const U4*)(V + row * 2048 + c0), f0); unpack8(*(const U4*)(V + (row + 1) * 2048 + c0), f1);
            const float m0 = rst[4 * l2], r0 = rst[4 * l2 + 1], m1 = rst[4 * l2 + 2], r1 = rst[4 * l2 + 3];
            const F4 ga = *(const F4*)(lng + c0), gb = *(const F4*)(lng + c0 + 4), ba = *(const F4*)(lnb + c0), bb = *(const F4*)(lnb + c0 + 4);
            const float gg[8] = {ga.x, ga.y, ga.z, ga.w, gb.x, gb.y, gb.z, gb.w}, bbv[8] = {ba.x, ba.y, ba.z, ba.w, bb.x, bb.y, bb.z, bb.w};
            unsigned* vt = (unsigned*)vnT + (cc * 8) * 68 + l2;
#pragma unroll
            for (int e = 0; e < 8; ++e) vt[e * 68] = pk2((f0[e] - m0) * r0 * gg[e] + bbv[e], (f1[e] - m1) * r1 * gg[e] + bbv[e]); }
        __syncthreads();
        F4 acc[8][2];
#pragma unroll
        for (int mt = 0; mt < 8; ++mt) { acc[mt][0] = (F4){0.f, 0.f, 0.f, 0.f}; acc[mt][1] = (F4){0.f, 0.f, 0.f, 0.f}; }
#pragma unroll
        for (int ks = 0; ks < 4; ++ks) {
            S8 vf[2], wf[8];
#pragma unroll
            for (int nt = 0; nt < 2; ++nt) vf[nt] = *(const S8*)(vnT + (32 * wave + 16 * nt + il) * 136 + 32 * ks + 8 * quad);
#pragma unroll
            for (int mt = 0; mt < 8; ++mt) wf[mt] = *(const S8*)(wsL + (16 * mt + il) * 136 + 32 * ks + 8 * quad);
#pragma unroll
            for (int mt = 0; mt < 8; ++mt)
#pragma unroll
                for (int nt = 0; nt < 2; ++nt) acc[mt][nt] = __builtin_amdgcn_mfma_f32_16x16x32_bf16(vf[nt], wf[mt], acc[mt][nt], 0, 0, 0);
        }
#pragma unroll
        for (int mt = 0; mt < 8; ++mt) { const int p = 16 * mt + il; const float b = gbs[g * 128 + p];
#pragma unroll
            for (int nt = 0; nt < 2; ++nt) { U2* up = (U2*)(U + ((size_t)n * 128 + p) * 2048 + g * 256 + 32 * wave + 16 * nt + 4 * quad); const U2 uu = *up;
                U2 o; o.x = pk2(bflo(uu.x) * (acc[mt][nt][0] + b), bfhi(uu.x) * (acc[mt][nt][1] + b)); o.y = pk2(bflo(uu.y) * (acc[mt][nt][2] + b), bfhi(uu.y) * (acc[mt][nt][3] + b)); *up = o; } }
    }
}
__device__ __forceinline__ void phase_attention(const u16* Qb, const u16* Kb, const u16* Vb, u16* Ob, unsigned char* lds, int bid, int G) {
    using namespace attn_body;
    for (int u = bid; u < 1024 + 16; u += G) {
        int qrow0, h, NT;
        if (u < 1024) { h = u >> 6; qrow0 = CTX + (u & 63) * 256; NT = M / 64; } else { h = u - 1024; qrow0 = 0; NT = CTX / 64; }
        attn_unit<8>(qrow0, h, NT, (const bf16*)Qb, (const bf16*)Kb, (const bf16*)Vb, (bf16*)Ob, (char*)lds);
    }
}
__device__ __forceinline__ void phase_hy_dwconv(const u16* P, const float* cw, const float* cb, u16* X0, u16* UT, unsigned char* lds, int bid, int G) {
    const int tid = TIDX(); u16* uL = (u16*)lds;
    const int cc = tid & 7, rg = tid >> 3;
    for (int it = bid; it < 65 * 16; it += G) {
        const int rt = it >> 4, ct = it & 15;
        __syncthreads();
        float uo[4][8];
#pragma unroll
        for (int grp = 0; grp < 3; ++grp) {
            const int col = grp * 1024 + ct * 64 + cc * 8;
            float w0[8], w1[8], w2[8], bb[8];
#pragma unroll
            for (int h2 = 0; h2 < 2; ++h2) { const F4 a = *(const F4*)(cw + col + 4 * h2), b = *(const F4*)(cw + 3072 + col + 4 * h2), c = *(const F4*)(cw + 6144 + col + 4 * h2), d = *(const F4*)(cb + col + 4 * h2);
#pragma unroll
                for (int e = 0; e < 4; ++e) { w0[4 * h2 + e] = a[e]; w1[4 * h2 + e] = b[e]; w2[4 * h2 + e] = c[e]; bb[4 * h2 + e] = d[e]; } }
            const int Rb = rt * 256 + rg * 4;
            const U4 zero = {0u, 0u, 0u, 0u};
            float pv[8], cv[8], nv[8];
            unpack8((Rb != 0 && Rb != CTX) ? *(const U4*)(P + (size_t)(Rb - 1) * 3072 + col) : zero, pv);
            unpack8(*(const U4*)(P + (size_t)Rb * 3072 + col), cv);
#pragma unroll
            for (int r = 0; r < 4; ++r) {
                const int R = Rb + r;
                unpack8((R != CTX - 1 && R != M - 1) ? *(const U4*)(P + (size_t)(R + 1) * 3072 + col) : zero, nv);
                float val[8];
#pragma unroll
                for (int e = 0; e < 8; ++e) { val[e] = pv[e] * w0[e] + cv[e] * w1[e] + nv[e] * w2[e] + bb[e]; pv[e] = cv[e]; cv[e] = nv[e]; }
                if (grp == 0) *(U4*)(X0 + (size_t)R * 1024 + ct * 64 + cc * 8) = pack8(val);
                else if (grp == 1) {
#pragma unroll
                    for (int e = 0; e < 8; ++e) uo[r][e] = val[e];
                } else {
#pragma unroll
                    for (int e = 0; e < 8; ++e) uo[r][e] *= val[e];
                }
            }
        }
#pragma unroll
        for (int e = 0; e < 8; ++e) { U2 o; o.x = pk2(uo[0][e], uo[1][e]); o.y = pk2(uo[2][e], uo[3][e]); *(U2*)(uL + (cc * 8 + e) * 264 + rg * 4) = o; }
        __syncthreads();
        { const int ch = tid >> 3, piece = tid & 7;
#pragma unroll
          for (int k2 = 0; k2 < 4; ++k2) { const int off = (piece + 8 * k2) * 8; *(U4*)(UT + (size_t)(ct * 64 + ch) * M + rt * 256 + off) = *(const U4*)(uL + ch * 264 + off); } }
    }
}
__device__ __forceinline__ float hy_delta(int d) { return 3.0701134573253946f + (float)d * ((15.350567286626973f - 3.0701134573253946f) / 1023.f); }
__device__ __forceinline__ void phase_hy_ktgen(const float* HID2, const float* w3, const float* skip, u16* KK, unsigned char* lds, int bid, int G) {
    const int tid = TIDX(), t = tid & 63, dg = __builtin_amdgcn_readfirstlane(tid >> 6);
    float* hs = (float*)lds; float* wf = hs + 64 * 65; float* wb = wf + 64 * 64;
    if (bid < 12) return;
    for (int it = bid - 12; it < 256 * 16; it += G - 12) {
        const int tt = it >> 4, dt = it & 15;
        __syncthreads();
#pragma unroll
        for (int i = 0; i < 8; ++i) { const int id = tid + NTHR * i, a = id >> 6, e = id & 63;
            hs[a * 65 + e] = HID2[(size_t)(CTX + 64 * tt + a) * 64 + e];
            wf[a * 64 + e] = w3[(size_t)a * 2048 + 64 * dt + e]; wb[a * 64 + e] = w3[(size_t)a * 2048 + 1024 + 64 * dt + e]; }
        __syncthreads();
        float af[8], ab[8];
#pragma unroll
        for (int q = 0; q < 8; ++q) { af[q] = 0.f; ab[q] = 0.f; }
#pragma unroll 4
        for (int e = 0; e < 64; ++e) { const float h = hs[t * 65 + e];
            const F4 f0 = *(const F4*)(wf + e * 64 + 8 * dg), f1 = *(const F4*)(wf + e * 64 + 8 * dg + 4), b0 = *(const F4*)(wb + e * 64 + 8 * dg), b1 = *(const F4*)(wb + e * 64 + 8 * dg + 4);
            af[0] += h * f0.x; af[1] += h * f0.y; af[2] += h * f0.z; af[3] += h * f0.w; af[4] += h * f1.x; af[5] += h * f1.y; af[6] += h * f1.z; af[7] += h * f1.w;
            ab[0] += h * b0.x; ab[1] += h * b0.y; ab[2] += h * b0.z; ab[3] += h * b0.w; ab[4] += h * b1.x; ab[5] += h * b1.y; ab[6] += h * b1.z; ab[7] += h * b1.w; }
        const int tpos = 64 * tt + t; const float tn = (float)tpos / 16383.f;
#pragma unroll
        for (int q = 0; q < 8; ++q) { const int d = 64 * dt + 8 * dg + q; const float dec = __expf(-tn * hy_delta(d));
            float vf = af[q] * dec; if (tpos == 0) vf += skip[d];
            KK[(size_t)d * 32768 + 16384 + tpos] = (u16)f2bf(vf);
            if (tpos == 0) KK[(size_t)d * 32768] = 0; else KK[(size_t)d * 32768 + 16384 - tpos] = (u16)f2bf(ab[q] * dec); }
    }
}
__device__ __forceinline__ int ur_phys(int g) { return (g & ~15) | ((g ^ (g >> 4)) & 15); }
__device__ __forceinline__ void conv_build_load(const unsigned* kk32, int k0, int wave, int lane, unsigned (&v)[18]) {
#pragma unroll
    for (int i = 0; i < 18; ++i) { const int idx = 8 * k0 + lane + 64 * i + (wave >> 1); v[i] = (idx < 16384 && i < 17) ? kk32[idx] : 0u; }
}
__device__ __forceinline__ void conv_build_store(unsigned* sh, int wave, int lane, const unsigned (&v)[18]) {
#pragma unroll
    for (int i = 0; i < 17; ++i) { const int w = lane + 64 * i; unsigned o = v[i];
        if (wave & 1) { unsigned nx = __shfl_down(v[i], 1); const unsigned n0 = __shfl(v[i + 1], 0); if (lane == 63) nx = n0; o = (v[i] >> 16) | (nx << 16); }
        if (w < 1064) sh[w] = o; }
}
__device__ __forceinline__ void phase_hy_conv(const u16* KK, const u16* UT, u16* YT, const float* HID2, const float* w3, const float* skip, unsigned char* lds, int bid, int G) {
    const int tid = TIDX(), lane = tid & 63, wave = __builtin_amdgcn_readfirstlane(tid >> 6), n32 = lane & 31, hi = lane >> 5;
    constexpr int UR_B = 0, UR_N = 20480, SH_B = UR_N * 2, SHB = 4416, SHBUF = 8 * SHB;
    u16* UR = (u16*)(lds + UR_B);
    for (int it = bid; it < 2048; it += G) {
        __syncthreads();
        if (it < 1024) {
            const int d = it;
            const unsigned* kk32 = (const unsigned*)(KK + (size_t)d * 32768);
            unsigned pv[18];
            conv_build_load(kk32, 0, wave, lane, pv);
            { U4* ur = (U4*)UR; const U4 zero = {0u, 0u, 0u, 0u}; for (int i = tid; i < UR_N / 8; i += NTHR) ur[i] = zero; }
            __syncthreads();
#pragma unroll
            for (int i = 0; i < 4; ++i) { const int s0 = (tid + NTHR * i) * 8; float f[8]; unpack8(*(const U4*)(UT + (size_t)d * M + CTX + s0), f);
#pragma unroll
                for (int e = 0; e < 8; ++e) { const int y = L + 2048 - (s0 + e); UR[(ur_phys(y >> 3) << 3) | (y & 7)] = (u16)f2bf(f[e]); } }
            conv_build_store((unsigned*)(lds + SH_B + wave * SHB), wave, lane, pv);
            __syncthreads();
            F16v acc0, acc1;
#pragma unroll
            for (int r = 0; r < 16; ++r) { acc0[r] = 0.f; acc1[r] = 0.f; }
            const int I = wave, ii = 32 * I + n32;
            const int gb = hi - 8 * ii + 256;
            const int aoff = SH_B + (n32 & 7) * SHB + ((n32 >> 3) * 8 + 8 * hi) * 2;
            for (int c = 0; c < 16; ++c) {
                const int k0 = 128 * c;
                if (c + 1 < 16) conv_build_load(kk32, k0 + 128, wave, lane, pv);
                if (c >= I && c <= I + 8) {
                    const unsigned char* ab = lds + aoff + (c & 1) * SHBUF;
#define CONV_A(kk) (*(const S8*)(ab + 32 * (kk)))
#define CONV_B(kk) (*(const S8*)(UR + (ur_phys(gb + 2 * (k0 + (kk))) << 3)))
#define CONV_MM(a_lo, a_hi, b) do { acc0 = __builtin_amdgcn_mfma_f32_32x32x16_bf16(a_lo, b, acc0, 0, 0, 0); acc1 = __builtin_amdgcn_mfma_f32_32x32x16_bf16(a_hi, b, acc1, 0, 0, 0); } while (0)
                    S8 ar[8], br[8];
#pragma unroll
                    for (int x = 0; x < 6; ++x) ar[x] = CONV_A(x);
#pragma unroll
                    for (int x = 0; x < 4; ++x) br[x] = CONV_B(x);
                    for (int k = 0; k < 128; k += 8) {
#pragma unroll
                        for (int j = 0; j < 8; ++j) {
                            ar[(6 + j) & 7] = CONV_A(k + 6 + j); br[(4 + j) & 7] = CONV_B(k + 4 + j);
                            __builtin_amdgcn_sched_barrier(0);
                            CONV_MM(ar[j & 7], ar[(j + 2) & 7], br[j & 7]);
                            __builtin_amdgcn_sched_barrier(0);
                        }
                    }
#undef CONV_A
#undef CONV_B
#undef CONV_MM
                }
                if (c + 1 < 16) conv_build_store((unsigned*)(lds + SH_B + ((c + 1) & 1) * SHBUF + wave * SHB), wave, lane, pv);
                __syncthreads();
            }
#pragma unroll
            for (int rg = 0; rg < 4; ++rg) { const int a0 = 8 * rg + 4 * hi;
                U2 o0; o0.x = pk2(acc0[4 * rg], acc0[4 * rg + 1]); o0.y = pk2(acc0[4 * rg + 2], acc0[4 * rg + 3]);
                U2 o1; o1.x = pk2(acc1[4 * rg], acc1[4 * rg + 1]); o1.y = pk2(acc1[4 * rg + 2], acc1[4 * rg + 3]);
                *(U2*)(YT + (size_t)d * M + CTX + 64 * ii + a0) = o0; *(U2*)(YT + (size_t)d * M + CTX + 64 * ii + 32 + a0) = o1; }
        } else {
            const int d = it - 1024; float* kkc = (float*)lds; float* uc = kkc + 512;
            if (tid < 511) { const int lag = tid - 255, m = lag < 0 ? -lag : lag; const float* hrow = HID2 + (size_t)m * 64; const float* wcol = w3 + (lag < 0 ? 1024 : 0) + d; float acc = 0.f;
#pragma unroll 8
                for (int e = 0; e < 64; ++e) acc += hrow[e] * wcol[(size_t)e * 2048];
                float v = acc * __expf(-((float)m / 255.f) * hy_delta(d)); if (lag == 0) v += skip[d]; kkc[tid] = v; }
            if (tid < 256) uc[tid] = bf1(UT[(size_t)d * M + tid]);
            __syncthreads();
            if (tid < 256) { float y = 0.f;
#pragma unroll 8
                for (int s = 0; s < 256; ++s) y += kkc[tid - s + 255] * uc[s];
                YT[(size_t)d * M + tid] = (u16)f2bf(y); }
        }
    }
}
__device__ __forceinline__ void phase_hy_tgate(u16* X0, const u16* YT, unsigned char* lds, int bid, int G) {
    const int tid = TIDX(); u16* yL = (u16*)lds;
    for (int it = bid; it < 65 * 16; it += G) {
        const int rt = it >> 4, ct = it & 15;
        __syncthreads();
        { const int ch = tid >> 3, piece = tid & 7;
#pragma unroll
          for (int k2 = 0; k2 < 4; ++k2) { const int off = (piece + 8 * k2) * 8; *(U4*)(yL + ch * 264 + off) = *(const U4*)(YT + (size_t)(ct * 64 + ch) * M + rt * 256 + off); } }
        __syncthreads();
        const int cc = tid & 7, rg = tid >> 3;
        float yv[4][8];
#pragma unroll
        for (int e = 0; e < 8; ++e) { const U2 w = *(const U2*)(yL + (cc * 8 + e) * 264 + rg * 4); yv[0][e] = bflo(w.x); yv[1][e] = bfhi(w.x); yv[2][e] = bflo(w.y); yv[3][e] = bfhi(w.y); }
#pragma unroll
        for (int r = 0; r < 4; ++r) { U4* xp = (U4*)(X0 + (size_t)(rt * 256 + rg * 4 + r) * 1024 + ct * 64 + cc * 8); float f[8]; unpack8(*xp, f);
#pragma unroll
            for (int e = 0; e < 8; ++e) f[e] *= yv[r][e];
            *xp = pack8(f); }
    }
}
__device__ __forceinline__ void phase_ssd_conv(u16* XBC, const u16* HALO, const float* cw, const float* cb, int bid, int G) {
    const int lane = TIDX() & 63, wave = __builtin_amdgcn_readfirstlane(TIDX() >> 6);
    const int gw = bid * NWAVES + wave, NGW = G * NWAVES;
    const U4 zero = {0u, 0u, 0u, 0u};
    for (int it = gw; it < (M / 32) * 6; it += NGW) {
        const int seg = it / 6, col = (it % 6) * 512 + 8 * lane;
        float w0[8], w1[8], w2[8], bb[8];
#pragma unroll
        for (int h2 = 0; h2 < 2; ++h2) { const F4 a = *(const F4*)(cw + col + 4 * h2), b = *(const F4*)(cw + 3072 + col + 4 * h2), c = *(const F4*)(cw + 6144 + col + 4 * h2), d = *(const F4*)(cb + col + 4 * h2);
#pragma unroll
            for (int e = 0; e < 4; ++e) { w0[4 * h2 + e] = a[e]; w1[4 * h2 + e] = b[e]; w2[4 * h2 + e] = c[e]; bb[4 * h2 + e] = d[e]; } }
        u16* base = XBC + (size_t)(seg * 32) * 3072 + col;
        U4 prevw = (seg == 0 || seg == CTX / 32) ? zero : *(const U4*)(HALO + ((size_t)(seg - 1) * 2 + 1) * 3072 + col);
        const U4 nextw = (seg == CTX / 32 - 1 || seg == M / 32 - 1) ? zero : *(const U4*)(HALO + ((size_t)(seg + 1) * 2) * 3072 + col);
#pragma unroll
        for (int half = 0; half < 2; ++half) {
            U4 rw[17];
#pragma unroll
            for (int r = 0; r < 17; ++r) { const int rr = 16 * half + r; rw[r] = rr < 32 ? *(const U4*)(base + (size_t)rr * 3072) : nextw; }
            float pv[8], cv[8], nv[8];
            unpack8(prevw, pv); unpack8(rw[0], cv);
#pragma unroll
            for (int r = 0; r < 16; ++r) {
                unpack8(rw[r + 1], nv);
                float o[8];
#pragma unroll
                for (int e = 0; e < 8; ++e) { o[e] = silu_f(pv[e] * w0[e] + cv[e] * w1[e] + nv[e] * w2[e] + bb[e]); pv[e] = cv[e]; cv[e] = nv[e]; }
                *(U4*)(base + (size_t)(16 * half + r) * 3072) = pack8(o);
            }
            prevw = rw[15];
        }
    }
}
__device__ __forceinline__ void phase_ssd_cb(const u16* XBC, u16* CB, u16* BT, const float* DT, const float* a_log, const float* dt_bias, float* ACS2, float* DTV, float* WV, float* TOT, unsigned char* lds, int bid, int G) {
    const int tid = TIDX(), lane = tid & 63, wave = __builtin_amdgcn_readfirstlane(tid >> 6), il = lane & 15, quad = lane >> 4;
    unsigned* T = (unsigned*)lds;
    for (int it = bid; it < 130 * 4; it += G) {
        const int c = it >> 2, g = it & 3;
        const int i = 16 * wave + il;
        __syncthreads();
#pragma unroll
        for (int q = 0; q < 2; ++q) { const int nc = 2 * wave + q;
            const U4 r0 = *(const U4*)(XBC + (size_t)(128 * c + 2 * lane) * 3072 + 2048 + 128 * g + 8 * nc), r1 = *(const U4*)(XBC + (size_t)(128 * c + 2 * lane + 1) * 3072 + 2048 + 128 * g + 8 * nc);
            const unsigned a[4] = {r0.x, r0.y, r0.z, r0.w}, b[4] = {r1.x, r1.y, r1.z, r1.w};
#pragma unroll
            for (int e2 = 0; e2 < 4; ++e2) { T[(8 * nc + 2 * e2) * 68 + lane] = (a[e2] & 0xffffu) | (b[e2] << 16); T[(8 * nc + 2 * e2 + 1) * 68 + lane] = (a[e2] >> 16) | (b[e2] & 0xffff0000u); } }
#pragma unroll
        for (int q2 = 0; q2 < 2; ++q2) { const int pr = 2 * wave + q2, dir = pr >> 3, h = 8 * g + (pr & 7), dh = dir * 32 + h;
            const float Ah = -__expf(a_log[dh]), dtb = dt_bias[dh];
            const size_t R0 = (size_t)c * 128;
            const float d0 = softplus_f(DT[(R0 + 2 * lane) * 64 + dh] + dtb), d1 = softplus_f(DT[(R0 + 2 * lane + 1) * 64 + dh] + dtb);
            const float a0 = d0 * Ah * 1.4426950408889634f, a1 = d1 * Ah * 1.4426950408889634f;
            float sc = a0 + a1, tot, c0, c1;
            if (dir == 0) {
#pragma unroll
                for (int o = 1; o < 64; o <<= 1) { const float t2 = __shfl_up(sc, o); if (lane >= o) sc += t2; }
                tot = __shfl(sc, 63); c0 = sc - a1; c1 = sc;
            } else {
#pragma unroll
                for (int o = 1; o < 64; o <<= 1) { const float t2 = __shfl_down(sc, o); if (lane + o < 64) sc += t2; }
                tot = __shfl(sc, 0); c0 = sc; c1 = sc - a0;
            }
            const size_t o2 = (size_t)dh * M + R0 + 2 * lane;
            *(F2*)(ACS2 + o2) = (F2){c0, c1}; *(F2*)(DTV + o2) = (F2){d0, d1};
            *(F2*)(WV + o2) = (F2){__builtin_amdgcn_exp2f(tot - c0) * d0, __builtin_amdgcn_exp2f(tot - c1) * d1};
            if (lane == 0) TOT[dh * 130 + c] = tot; }
        S8 cf[4];
#pragma unroll
        for (int ks = 0; ks < 4; ++ks) cf[ks] = *(const S8*)(XBC + (size_t)(128 * c + i) * 3072 + 2560 + 128 * g + 32 * ks + 8 * quad);
#pragma unroll
        for (int jt = 0; jt < 8; ++jt) {
            F4 acc = {0.f, 0.f, 0.f, 0.f};
#pragma unroll
            for (int ks = 0; ks < 4; ++ks) { const S8 bfr = *(const S8*)(XBC + (size_t)(128 * c + 16 * jt + il) * 3072 + 2048 + 128 * g + 32 * ks + 8 * quad);
                acc = __builtin_amdgcn_mfma_f32_16x16x32_bf16(bfr, cf[ks], acc, 0, 0, 0); }
            U2 o; o.x = pk2(acc[0], acc[1]); o.y = pk2(acc[2], acc[3]);
            *(U2*)(CB + (((size_t)c * 4 + g) * 128 + i) * 128 + 16 * jt + 4 * quad) = o;
        }
        __syncthreads();
        { const int n = tid >> 2, piece = tid & 3;
#pragma unroll
          for (int q = 0; q < 4; ++q) *(U4*)(BT + (((size_t)c * 4 + g) * 128 + n) * 128 + (piece * 4 + q) * 8) = *(const U4*)(T + n * 68 + (piece * 4 + q) * 4); }
    }
}
__device__ __forceinline__ int scan_chunk(int dir, int ci) { return dir == 0 ? ci : (ci < 2 ? 1 - ci : 131 - ci); }
__device__ __forceinline__ void phase_ssd_scan(const u16* XBC, const float* ACS2, const float* DTV, const float* WV, const float* TOT, const u16* CB, const u16* BT, u16* YF, u16* YB, u16* YDUMMY, unsigned char* lds, int bid, int G) {
    const int tid = TIDX(), lane = tid & 63, wave = __builtin_amdgcn_readfirstlane(tid >> 6), il = lane & 15, quad = lane >> 4;
    float* fb = (float*)lds;
    u16* XTb = (u16*)(lds + 4096);
    u16* HBFb = (u16*)(lds + 4096 + 4 * 4352);
    for (int it = bid; it < 256; it += G) {
        const int dir = it >> 7, h = (it & 127) >> 2, pq = it & 3, g = h >> 3;
        const size_t dhM = (size_t)(dir * 32 + h) * M; const float* totp = TOT + (dir * 32 + h) * 130;
        u16* Y = dir ? YB : YF;
        __syncthreads();
        for (int i = tid; i < 16 * 136; i += NTHR) HBFb[i] = 0;
        F4 hst = {0.f, 0.f, 0.f, 0.f};
        float pacs = 0.f, pdt = 0.f, pw = 0.f, ptot = 0.f; U4 pxr = {0u, 0u, 0u, 0u}; U4 pcf[4], pcb[4], pbt[4];
#pragma unroll
        for (int k = 0; k < 4; ++k) { pcf[k] = (U4){0u, 0u, 0u, 0u}; pcb[k] = (U4){0u, 0u, 0u, 0u}; pbt[k] = (U4){0u, 0u, 0u, 0u}; }
        const int xrow = (tid >> 1) & 127, xcol = h * 64 + pq * 16 + 8 * (tid & 1);
        const int irow = 16 * wave + il;
#define SCAN_PREF_A(cc) do { const size_t R0_ = (size_t)(cc) * 128; ptot = totp[cc]; \
            pxr = *(const U4*)(XBC + (R0_ + xrow) * 3072 + xcol); pw = WV[dhM + R0_ + xrow]; \
            pacs = ACS2[dhM + R0_ + (tid & 127)]; pdt = DTV[dhM + R0_ + (tid & 127)]; } while (0)
#define SCAN_PREF_B(cc) do { const size_t R0_ = (size_t)(cc) * 128; const size_t cg_ = ((size_t)(cc) * 4 + g) * 128 + irow; \
            _Pragma("unroll") for (int ks = 0; ks < 4; ++ks) { pbt[ks] = *(const U4*)(BT + cg_ * 128 + 32 * ks + 8 * quad); \
                pcf[ks] = *(const U4*)(XBC + (R0_ + irow) * 3072 + 2560 + 128 * g + 32 * ks + 8 * quad); pcb[ks] = *(const U4*)(CB + cg_ * 128 + 32 * ks + 8 * quad); } } while (0)
#define SCAN_STAGE(bsel) do { float* fbb = fb + (bsel) * 400; \
            if (wave < 4) { \
                if (wave < 2) { fbb[tid] = pacs; fbb[128 + tid] = pdt; if (tid == 0) fbb[384] = ptot; } \
                float f_[8]; unpack8(pxr, f_); u16* xt_ = XTb + (bsel) * (2 * 16 * 136); \
                _Pragma("unroll") for (int e = 0; e < 8; ++e) { const unsigned pw_ = pk2(f_[e], f_[e] * pw); xt_[(8 * (tid & 1) + e) * 136 + xrow] = (u16)(pw_ & 0xffffu); xt_[16 * 136 + (8 * (tid & 1) + e) * 136 + xrow] = (u16)(pw_ >> 16); } } } while (0)
        SCAN_PREF_A(scan_chunk(dir, 0)); SCAN_PREF_B(scan_chunk(dir, 0));
        SCAN_STAGE(0);
        SCAN_PREF_A(scan_chunk(dir, 1));
        for (int ci = 0; ci < 130; ++ci) {
            const int c = scan_chunk(dir, ci); const int bsel = ci & 1;
            const size_t R0 = (size_t)c * 128;
            const float* acs = fb + bsel * 400; const float* dtv = acs + 128; const u16* XT = XTb + bsel * (2 * 16 * 136); const u16* XTW = XT + 16 * 136; const u16* HBF = HBFb + bsel * (16 * 136);
            LDS_BAR();
            U4 cf[4], cbv[4], bt[4];
#pragma unroll
            for (int k = 0; k < 4; ++k) { cf[k] = pcf[k]; cbv[k] = pcb[k]; bt[k] = pbt[k]; }
            if (ci + 1 < 130) SCAN_PREF_B(scan_chunk(dir, ci + 1));
            const float tot = acs[384];
            {
                const int i = irow; const float acs_i = acs[i];
                F4 aoffv = {0.f, 0.f, 0.f, 0.f}, acc = {0.f, 0.f, 0.f, 0.f};
#pragma unroll
                for (int ks = 0; ks < 4; ++ks) { const S8 hf = *(const S8*)(HBF + il * 136 + 32 * ks + 8 * quad);
                    aoffv = __builtin_amdgcn_mfma_f32_16x16x32_bf16(__builtin_bit_cast(S8, cf[ks]), hf, aoffv, 0, 0, 0); }
                const int klo = dir == 0 ? 0 : (wave >> 1), khi = dir == 0 ? (wave >> 1) : 3;
#pragma unroll
                for (int ks = 0; ks < 4; ++ks) if (ks >= klo && ks <= khi) {
                    asm volatile("" ::: "memory");
                    float f[8]; unpack8(cbv[ks], f);
                    const int j0 = 32 * ks + 8 * quad;
                    const F4 aj0 = *(const F4*)(acs + j0), aj1 = *(const F4*)(acs + j0 + 4), dj0 = *(const F4*)(dtv + j0), dj1 = *(const F4*)(dtv + j0 + 4);
                    const float aj[8] = {aj0.x, aj0.y, aj0.z, aj0.w, aj1.x, aj1.y, aj1.z, aj1.w}, dj[8] = {dj0.x, dj0.y, dj0.z, dj0.w, dj1.x, dj1.y, dj1.z, dj1.w};
#pragma unroll
                    for (int e = 0; e < 8; ++e) { const int j = j0 + e; const bool ok = dir == 0 ? (j <= i) : (j >= i);
                        f[e] = f[e] * __builtin_amdgcn_exp2f(ok ? acs_i - aj[e] : -INFINITY) * dj[e]; }
                    const U4 gw = pack8(f); const S8 xf = *(const S8*)(XT + il * 136 + 32 * ks + 8 * quad);
                    acc = __builtin_amdgcn_mfma_f32_16x16x32_bf16(__builtin_bit_cast(S8, gw), xf, acc, 0, 0, 0);
                }
                const F4 ar = *(const F4*)(acs + 16 * wave + 4 * quad);
#pragma unroll
                for (int r = 0; r < 4; ++r) { u16* yp = c >= 2 ? Y + (R0 - CTX + 16 * wave + 4 * quad + r) * 2048 + h * 64 + pq * 16 + il : YDUMMY + tid * 4 + r;
                    *yp = (u16)f2bf(acc[r] + __builtin_amdgcn_exp2f(ar[r]) * aoffv[r]); }
            }
            F4 sacc = {0.f, 0.f, 0.f, 0.f};
#pragma unroll
            for (int ks = 0; ks < 4; ++ks) { const S8 xa = *(const S8*)(XTW + il * 136 + 32 * ks + 8 * quad);
                sacc = __builtin_amdgcn_mfma_f32_16x16x32_bf16(xa, __builtin_bit_cast(S8, bt[ks]), sacc, 0, 0, 0); }
            hst = hst * __builtin_amdgcn_exp2f(tot) + sacc;
            if (ci + 1 < 130) { SCAN_STAGE(bsel ^ 1); if (ci + 2 < 130) SCAN_PREF_A(scan_chunk(dir, ci + 2)); }
#pragma unroll
            for (int r = 0; r < 4; ++r) HBFb[(bsel ^ 1) * (16 * 136) + (4 * quad + r) * 136 + 16 * wave + il] = (u16)f2bf(hst[r]);
        }
#undef SCAN_PREF_A
#undef SCAN_PREF_B
#undef SCAN_STAGE
    }
}
constexpr int NPHASES = 38;
enum { K_NONE = 0, K_STORE, K_GM, K_SSDIN, K_SWIGLU, K_RESID };
__device__ __forceinline__ size_t w_fi(int ly) { return ly == 0 ? W_FI0 : ly == 1 ? W_FI1 : ly == 2 ? W_FI2 : W_FI3; }
__device__ __forceinline__ size_t w_fo(int ly) { return ly == 0 ? W_FO0 : ly == 1 ? W_FO1 : ly == 2 ? W_FO2 : W_FO3; }

__device__ __forceinline__ void run_phase(const Args& a, int ph, unsigned char* lds, int bid, int G) {
    unsigned char* ws = a.ws;
    float* X = (float*)(ws + WS_X); u16* H = (u16*)(ws + WS_H); float* MOD = (float*)(ws + WS_MOD);
    unsigned char* outb = (unsigned char*)a.out;
    float* PART = (float*)(ws + WS_PART);
    int kind = K_NONE; const u16* gA = nullptr; const u16* gB = nullptr; int gM = M, gN = 0, gK = 0;
    u16* gdst = nullptr; int gldc = 0; float* gX = X; const float* gl = nullptr; const float* gc = nullptr; int gctx = 1;
    const int ly = ph <= 8 ? 0 : ph <= 16 ? 1 : ph <= 26 ? 2 : 3;
    const float* modL = MOD + (size_t)(ly * 2 + 0) * 6144; const float* modC = MOD + (size_t)(ly * 2 + 1) * 6144;
    const int ffn0 = ly == 0 ? 6 : ly == 1 ? 14 : ly == 2 ? 24 : 34;
    const int n1 = ly == 0 ? 1 : ly == 1 ? 9 : ly == 2 ? 17 : 27;
    const bool latonly = (ly == 3);
    if (ph == 0) { phase_prologue(a, lds, bid, G); }
    else if (ph == n1) {
        if (ly == 0) phase_norm_mod((float*)a.in[I_CTX], a.in[I_X], X, a.in[I_N1G], modL, modC, 0, 1024, H, 0, nullptr, 0, nullptr, bid, G);
        else phase_norm_mod(X, X + (size_t)CTX * D, nullptr, a.in[I_N1G] + ly * D, modL, modC, 0, 1024, H, 0, PART, 11, MOD + (size_t)((ly - 1) * 2 + 1) * 6144 + 5120, bid, G);
    }
    else if (ph == ffn0) { phase_norm_mod(X, X + (size_t)CTX * D, nullptr, a.in[I_N2G] + ly * D, modL, modC, 3072, 4096, H, latonly ? CTX : 0, latonly ? nullptr : PART, ly == 0 ? 8 : 4, modC + 2048, bid, G); }
    else if (ph == ffn0 + 1) { kind = K_SWIGLU; gA = H + (latonly ? (size_t)CTX * D : 0); gB = (const u16*)(ws + w_fi(ly)); gM = latonly ? L : M; gN = 5632; gK = 1024; gdst = (u16*)(ws + B_ACT); }
    else if (ph == ffn0 + 2) { kind = K_RESID; gA = (const u16*)(ws + B_ACT); gB = (const u16*)(ws + w_fo(ly)); gM = latonly ? L : M; gN = 1024; gK = 2816;
        gX = X + (latonly ? (size_t)CTX * D : 0); gl = modL + 5120; gc = modC + 5120; gctx = latonly ? 0 : 1; }
    else switch (ph) {
        case 2: kind = K_GM; gA = H; gB = (const u16*)(ws + W_GMI); gN = 4096; gK = 1024; break;
        case 4: phase_spatial((u16*)(ws + B_U), (const u16*)(ws + B_V), (const float*)(ws + WS_STATSP), a.in[I_GMWS], a.in[I_GMBS], a.in[I_GMLG], a.in[I_GMLB], lds, bid, G); break;
        case 5: kind = K_RESID; gA = (const u16*)(ws + B_U); gB = (const u16*)(ws + W_GMO); gN = 1024; gK = 2048; gl = modL + 2048; gc = modC + 2048; break;
        case 10: kind = K_STORE; gA = H; gB = (const u16*)(ws + W_QKV); gN = 1536; gK = 1024; gdst = (u16*)(ws + B_QKVR); gldc = 1536; break;
        case 11: phase_qk_rope((const u16*)(ws + B_QKVR), a.in[I_ATQG], a.in[I_ATKG], (u16*)(ws + B_Q), (u16*)(ws + B_K), (u16*)(ws + B_VV), bid, G); break;
        case 12: phase_attention((const u16*)(ws + B_Q), (const u16*)(ws + B_K), (const u16*)(ws + B_VV), (u16*)(ws + B_QKVR), lds, bid, G); break;
        case 13: kind = K_RESID; gA = (const u16*)(ws + B_QKVR); gB = (const u16*)(ws + W_ATO); gN = 1024; gK = 1024; gl = modL + 2048; gc = modC + 2048; break;
        case 18: kind = K_STORE; gA = H; gB = (const u16*)(ws + W_HYI); gN = 3072; gK = 1024; gdst = (u16*)(ws + B_P); gldc = 3072; break;
        case 19: phase_hy_dwconv((const u16*)(ws + B_P), a.in[I_HYCW], a.in[I_HYCB], (u16*)(ws + B_X0), (u16*)(ws + B_UT), lds, bid, G); break;
        case 21: phase_hy_conv((const u16*)(outb + OUT_KK), (const u16*)(ws + B_UT), (u16*)(ws + B_YT), (const float*)(ws + WS_HID2), a.in[I_HYW3], a.in[I_HYSK], lds, bid, G); break;
        case 22: phase_hy_tgate((u16*)(ws + B_X0), (const u16*)(ws + B_YT), lds, bid, G); break;
        case 23: kind = K_RESID; gA = (const u16*)(ws + B_X0); gB = (const u16*)(ws + W_HYO); gN = 1024; gK = 1024; gl = modL + 2048; gc = modC + 2048; break;
        case 28: kind = K_SSDIN; gA = H; gB = (const u16*)(ws + W_SSI); gN = 5376; gK = 1024; break;
        case 29: phase_ssd_conv((u16*)(ws + B_XBC), (const u16*)(outb + OUT_HALO), a.in[I_SSCW], a.in[I_SSCB], bid, G); break;
        case 30: phase_ssd_cb((const u16*)(ws + B_XBC), (u16*)(ws + WS_CB), (u16*)(ws + WS_BT), (const float*)(ws + B_DT), a.in[I_SSAL], a.in[I_SSDB], (float*)(ws + WS_ACS2), (float*)(ws + WS_DTV), (float*)(ws + WS_WV), (float*)(ws + WS_TOT), lds, bid, G); break;
        case 31: phase_ssd_scan((const u16*)(ws + B_XBC), (const float*)(ws + WS_ACS2), (const float*)(ws + WS_DTV), (const float*)(ws + WS_WV), (const float*)(ws + WS_TOT), (const u16*)(ws + WS_CB), (const u16*)(ws + WS_BT), (u16*)(ws + WS_YF), (u16*)outb, (u16*)(ws + 16384), lds, bid, G); break;
        case 32: phase_ssd_finish((const u16*)(ws + WS_YF), (const u16*)outb, (const u16*)(ws + B_XBC), (u16*)(ws + B_Z), a.in[I_SSDS], a.in[I_SSNG], bid, G); break;
        case 33: kind = K_RESID; gA = (const u16*)(ws + B_Z) + (size_t)CTX * 2048; gB = (const u16*)(ws + W_SSO); gM = L; gN = 1024; gK = 2048; gX = X + (size_t)CTX * D; gl = modL + 2048; gc = modC + 2048; gctx = 0; break;
        case 37: phase_final(X, a.in[I_FING], a.out, bid, G); break;
        default: break;
    }
    if (kind != K_NONE) {
        const bool split = (kind == K_RESID) && gctx;
        if (split) { gA += (size_t)CTX * gK; gM = L; gX = X + (size_t)CTX * D; gctx = 0; }
        pg8::Gemm g{gA, gB, gM, gN, gK, gK}; pg8::StaticOrder S; S.init(gM, gN, G, bid);
        PG8_LAS unsigned char* l3 = (PG8_LAS unsigned char*)lds;
        if (kind == K_STORE) { pg8::EpiStore<0, pg8::RouterSimple> E{pg8::RouterSimple{gdst, gldc}}; pg8::gemm_phase<pg8::EpiStore<0, pg8::RouterSimple>, pg8::StaticOrder, true, true>(l3, g, S, E);
            if (ph == 10 && bid >= 134) convert_layer(a, 3, lds, bid - 134, G - 134);
            if (ph == 18) phase_hy_ktgen((const float*)(ws + WS_HID2), a.in[I_HYW3], a.in[I_HYSK], (u16*)(outb + OUT_KK), lds, bid, G); }
        else if (kind == K_GM) { pg8::EpiGmIn E{(u16*)(ws + B_U), (u16*)(ws + B_V), (float*)(ws + WS_STATSP)}; pg8::gemm_phase<pg8::EpiGmIn, pg8::StaticOrder, true, true>(l3, g, S, E);
            if (bid >= 16) convert_layer(a, 1, lds, bid - 16, G - 16); }
        else if (kind == K_SSDIN) { pg8::EpiSsdIn E{(u16*)(ws + B_Z), (u16*)(ws + B_XBC), (float*)(ws + B_DT), (u16*)(outb + OUT_HALO)}; pg8::gemm_phase<pg8::EpiSsdIn, pg8::StaticOrder, true, true>(l3, g, S, E); }
        else if (kind == K_SWIGLU) { pg8::EpiSwiglu E{gdst}; pg8::gemm_phase<pg8::EpiSwiglu, pg8::StaticOrder, true, true>(l3, g, S, E);
            if (ph == 7 && bid >= 150) convert_layer(a, 2, lds, bid - 150, G - 150); }
        else {
            if (split) { pg8::Gemm g2{gA - (size_t)CTX * gK, gB, CTX, gN, gK, 256}; pg8::SplitKOrder S2; S2.init(gN, gK / 256, G, bid); pg8::EpiPartial E2{PART};
                pg8::gemm_phase<pg8::EpiPartial, pg8::SplitKOrder, false, true>(l3, g2, S2, E2);
                __builtin_amdgcn_sched_barrier(0); }
            pg8::EpiResid E{gX, gl, gc, gctx, ph == 5 ? a.in[I_X] : (const float*)gX}; pg8::gemm_phase<pg8::EpiResid, pg8::StaticOrder, true, true>(l3, g, S, E); }
    }
}

#define XB_TMO      128
#define XB_XCNT(j)  (256  + 64 * (j))
#define XB_XSUB(j)  (1280 + 64 * (j))
#define XB_XGEN(j)  (2304 + 64 * (j))
#define XB_TOP      3328
#define XB_TOPGEN   3392
#define XCD_BAR_WORDS 3456
#define XB_SPIN_CAP (1u << 18)

__device__ __forceinline__ unsigned xb_ld(unsigned* p)              { return __hip_atomic_load(p, __ATOMIC_RELAXED, __HIP_MEMORY_SCOPE_AGENT); }
__device__ __forceinline__ unsigned xb_add(unsigned* p, unsigned v) { return __hip_atomic_fetch_add(p, v, __ATOMIC_RELAXED, __HIP_MEMORY_SCOPE_AGENT); }
__device__ __forceinline__ unsigned xb_xcc_id() { return (unsigned)__builtin_amdgcn_s_getreg((3 << 11) | 20) & 0xFu; }
#define XB_SPIN(cond, bar) do { unsigned _sp = 0; while (cond) { __builtin_amdgcn_s_sleep(1); \
    if ((++_sp & 255u) == 0u) { if (xb_ld(&(bar)[XB_TMO])) break; if (_sp > XB_SPIN_CAP) { atomicAdd(&(bar)[XB_TMO], 1u); break; } } } } while (0)

struct XcdBarrier {
    unsigned* bar; unsigned x;
    volatile LAS unsigned* st;
};

__device__ __forceinline__ XcdBarrier xcd_barrier_post(unsigned* bar, volatile LAS unsigned* st) {
    XcdBarrier b; b.bar = bar; b.x = xb_xcc_id(); b.st = st;
    if (TIDX() == 0) (void)xb_add(&bar[XB_XCNT(b.x)], 1u);
    return b;
}
__device__ __forceinline__ void xcd_barrier_complete(unsigned* bar, unsigned x, unsigned& nloc, unsigned& nx) {
    const unsigned G = gridDim.x * gridDim.y * gridDim.z;
    unsigned sum, cnt, mine, sp = 0u;
    for (;;) {
        sum = 0u; cnt = 0u; mine = 0u;
#pragma unroll
        for (unsigned j = 0; j < 16; ++j) { const unsigned c = xb_ld(&bar[XB_XCNT(j)]); sum += c; cnt += (c > 0u) ? 1u : 0u; mine = (j == x) ? c : mine; }
        if (sum == G) break;
        __builtin_amdgcn_s_sleep(1);
        if ((++sp & 255u) == 0u) { if (xb_ld(&bar[XB_TMO])) break; if (sp > XB_SPIN_CAP) { atomicAdd(&bar[XB_TMO], 1u); break; } }
    }
    nloc = mine > 0u ? mine : 1u; nx = cnt > 0u ? cnt : 1u;
}

__device__ __forceinline__ void xcd_barrier(const XcdBarrier& b) {
    asm volatile("s_waitcnt vmcnt(0)" ::: "memory");
    __syncthreads();
    if (TIDX() == 0) {
        unsigned* bar = b.bar;
        __builtin_amdgcn_s_waitcnt(0);
        unsigned nloc = b.st[0], nx = b.st[1];
        if (nloc == 0u) { xcd_barrier_complete(bar, b.x, nloc, nx); b.st[0] = nloc; b.st[1] = nx; }
        const unsigned old = xb_add(&bar[XB_XSUB(b.x)], 1u);
        const unsigned gen = old / nloc;
        if (old + 1u == (gen + 1u) * nloc) {
            __builtin_amdgcn_fence(__ATOMIC_RELEASE, "agent");
            asm volatile("s_waitcnt vmcnt(0)" ::: "memory");
            const unsigned og = xb_add(&bar[XB_TOP], 1u);
            const unsigned tg = og / nx;
            if (og + 1u == (tg + 1u) * nx) xb_add(&bar[XB_TOPGEN], 1u);
            else XB_SPIN(xb_ld(&bar[XB_TOPGEN]) == tg, bar);
            __builtin_amdgcn_fence(__ATOMIC_ACQUIRE, "agent");
            xb_add(&bar[XB_XGEN(b.x)], 1u);
            asm volatile("s_waitcnt vmcnt(0)" ::: "memory");
        } else {
            XB_SPIN(xb_ld(&bar[XB_XGEN(b.x)]) == gen, bar);
            __builtin_amdgcn_fence(__ATOMIC_ACQUIRE, "agent");
            asm volatile("s_waitcnt vmcnt(0)" ::: "memory");
        }
    }
    __syncthreads();
}


#if MK_MULTI_LAUNCH
template <int PH> __global__ void __launch_bounds__(NTHR, 2) k_phase(Args a) {
    extern __shared__ __attribute__((aligned(16))) unsigned char lds[];
    run_phase(a, PH, lds, blockIdx.x, gridDim.x);
}
typedef void (*phase_kernel_t)(Args);
template <int... I> static void fill_table(phase_kernel_t* t, std::integer_sequence<int, I...>) { ((t[I] = k_phase<I>), ...); }
#define MEGA_K k_phase<0>
#else
typedef const __attribute__((address_space(4))) Args* kargs_t;
constexpr int MISC_OFF = LDS_BYTES - 128;
template <int PH> __device__ __forceinline__ void run_from(unsigned char* lds, const XcdBarrier& bar) {
    if constexpr (PH == 3 || PH == 20) { run_from<PH + 1>(lds, bar); }
    else if constexpr (PH < NPHASES) {
        {
#if defined(__HIP_DEVICE_COMPILE__)
            kargs_t ap = (kargs_t)__builtin_amdgcn_kernarg_segment_ptr();
            asm volatile("" : "+s"(ap));
            Args la;
            for (int i = 0; i < 40; ++i) la.in[i] = ap->in[i];
            la.out = ap->out; la.ws = ap->ws; la.ph_lo = 0; la.ph_hi = NPHASES;
            run_phase(la, PH, lds, blockIdx.x, gridDim.x);
#if defined(PROBE_REPEAT)
            if constexpr (PROBE_REPEAT(PH)) { xcd_barrier(bar); run_phase(la, PH, lds, blockIdx.x, gridDim.x); }
#endif
#endif
        }
        if constexpr (PH + 1 < NPHASES) {
            xcd_barrier(bar);
            run_from<PH + 1>(lds, bar);
        }
    }
}
__global__ void __launch_bounds__(NTHR, 2) mega_fwd(Args a) {
    extern __shared__ __attribute__((aligned(16))) unsigned char lds[];
    volatile LAS unsigned* misc = (volatile LAS unsigned*)((LAS unsigned char*)lds + MISC_OFF);
    if (TIDX() < 32) misc[TIDX()] = 0u;
    if (blockIdx.x == 0) { unsigned* bw = (unsigned*)a.ws; for (int i = TIDX(); i < XCD_BAR_WORDS; i += NTHR) bw[i] = 0u; }
    __syncthreads();
    cg::this_grid().sync();
    const XcdBarrier bar = xcd_barrier_post((unsigned*)a.ws, misc + 8);
    run_from<0>(lds, bar);
}
#define MEGA_K mega_fwd
#endif

extern "C" void kernel_launch(void* const* d_in, const int* in_sizes, int n_in, void* d_out, int out_size, void* d_ws, size_t ws_size, hipStream_t stream) {
    static int grid = 0;
    if (grid == 0) {
        if (n_in != 40 || out_size != L * D || ws_size < WS_END) { fprintf(stderr, "kernel_launch: unexpected shapes (n_in %d, out %d, ws %zu, need %zu)\n", n_in, out_size, ws_size, (size_t)WS_END); grid = -1; return; }
        int dev = 0, cus = 0, per_cu = 0;
        (void)hipGetDevice(&dev); (void)hipDeviceGetAttribute(&cus, hipDeviceAttributeMultiprocessorCount, dev);
        if (hipFuncSetAttribute((const void*)MEGA_K, hipFuncAttributeMaxDynamicSharedMemorySize, LDS_BYTES) != hipSuccess) { fprintf(stderr, "kernel_launch: hipFuncSetAttribute failed\n"); grid = -1; return; }
        if (hipOccupancyMaxActiveBlocksPerMultiprocessor(&per_cu, (const void*)MEGA_K, NTHR, LDS_BYTES) != hipSuccess || per_cu < 1) per_cu = 1;
        (void)hipGetLastError();
        grid = cus * per_cu;
        if (grid <= 0) grid = 256;
    }
    if (grid < 0) return;
    Args a{};
    for (int i = 0; i < 40; ++i) a.in[i] = (const float*)d_in[i];
    a.out = (float*)d_out; a.ws = (unsigned char*)d_ws;
#if MK_MULTI_LAUNCH
    static phase_kernel_t table[NPHASES]; static bool tinit = false;
    if (!tinit) { fill_table(table, std::make_integer_sequence<int, NPHASES>{}); for (int ph = 0; ph < NPHASES; ++ph) (void)hipFuncSetAttribute((const void*)table[ph], hipFuncAttributeMaxDynamicSharedMemorySize, LDS_BYTES); tinit = true; }
    for (int ph = 0; ph < NPHASES; ++ph) { a.ph_lo = ph; a.ph_hi = ph + 1; hipLaunchKernelGGL(table[ph], dim3(grid), dim3(NTHR), LDS_BYTES, stream, a); }
#else
    a.ph_lo = 0; a.ph_hi = NPHASES;
    void* args[] = {&a};
    hipError_t e = hipLaunchCooperativeKernel((const void*)mega_fwd, dim3(grid), dim3(NTHR), args, LDS_BYTES, stream);
    if (e != hipSuccess) fprintf(stderr, "cooperative launch failed: %s (grid %d)\n", hipGetErrorString(e), grid);
#endif
}
```

```cpp
#include <hip/hip_runtime.h>
#include <hip/hip_cooperative_groups.h>
#include <hip/hip_bf16.h>
#include <cstdio>
#include <cstdint>
#include <cmath>
#include <utility>
namespace cg = cooperative_groups;
__device__ __forceinline__ int TIDX() { int t = threadIdx.x; asm volatile("" : "+v"(t)); return t; }
#ifndef MK_MULTI_LAUNCH
#define MK_MULTI_LAUNCH 0
#endif
__device__ __forceinline__ float silu_f(float x) { return x * __builtin_amdgcn_rcpf(1.0f + __expf(-x)); }
namespace pg8 {
#define PG8_LAS __attribute__((address_space(3)))
typedef unsigned short bf16_t;
typedef short bf16x8 __attribute__((ext_vector_type(8)));
typedef float f32x4 __attribute__((ext_vector_type(4)));
typedef unsigned u32x4 __attribute__((ext_vector_type(4)));
constexpr int BM = 256, BK = 64, HALF = 128, HTB = HALF * BK * 2  , STAGE_BYTES = 8 * HTB, NXCD = 8, WGM = 8;

__host__ __device__ __forceinline__ int lds_byte(int r, int c) { const int st = (r >> 4) * 2 + (c >> 5), rr = r & 15, cc = c & 31, ob = rr * 64 + cc * 2; return st * 1024 + (ob ^ (((ob >> 9) & 1) << 5)); }
__host__ __device__ __forceinline__ void stage_rc(int b, int& R, int& C) { const int st = b / 1024, sb = b % 1024, swz = sb ^ (((sb >> 9) & 1) << 5); R = (st >> 1) * 16 + swz / 64; C = (st & 1) * 32 + (swz % 64) / 2; }
__host__ __device__ __forceinline__ int perm32(int rho) { const int n = rho >> 4, i = rho & 15; return 8 * (i >> 2) + 4 * n + (i & 3); }

struct Unit { int pm, pn, kz; };
struct Gemm { const bf16_t* A; const bf16_t* Bt; int M, N, K, kloop; };

struct StaticOrder {
    int nM, nN, nwg, G, c;
    __host__ __device__ void init(int M, int N, int G_, int c_) { nM = M / BM; nN = N / BM; nwg = nM * nN; G = G_; c = c_; }
    __host__ __device__ bool next(int i, Unit& u) const {
        const long L = (long)i * G + c; if (L >= nwg) return false;
        int wgid = (int)L; { const int q = nwg / NXCD, r = nwg % NXCD, xcd = wgid % NXCD, off = wgid / NXCD; wgid = (xcd < r ? xcd * (q + 1) : r * (q + 1) + (xcd - r) * q) + off; }
        const int nig = WGM * nN, gid = wgid / nig, fm = gid * WGM, gsz = (nM - fm) < WGM ? (nM - fm) : WGM;
        u.pm = fm + ((wgid % nig) % gsz); u.pn = (wgid % nig) / gsz; u.kz = 0; return true;
    }
    __device__ __forceinline__ void a_ready(const Unit&) const {}
    __device__ __forceinline__ void done(const Unit&) const {}
};

__device__ __forceinline__ unsigned cvt_pk_bf16(float lo, float hi) { unsigned r; asm volatile("v_cvt_pk_bf16_f32 %0, %1, %2" : "=v"(r) : "v"(lo), "v"(hi)); return r; }
typedef float f32x2 __attribute__((ext_vector_type(2)));
__device__ __forceinline__ f32x2 gelu_pk(f32x2 v) {
    const f32x2 av = __builtin_elementwise_abs(v), d = av * 0.2316418882f + 1.0f;
    f32x2 t; t.x = __builtin_amdgcn_rcpf(d.x); t.y = __builtin_amdgcn_rcpf(d.y);
    f32x2 q = t * 0.5307027145f + (-0.7265760135f); q = q * t + 0.7107068705f; q = q * t + (-0.142248368f); q = q * t + 0.127414796f; q = q * t;
    const f32x2 s = (v * v) * (-0.72134752044f);
    f32x2 e; e.x = __builtin_amdgcn_exp2f(s.x); e.y = __builtin_amdgcn_exp2f(s.y);
    const f32x2 m = v * (q * e), r = v - m;
    f32x2 o; o.x = v.x < 0.f ? m.x : r.x; o.y = v.y < 0.f ? m.y : r.y; return o;
}

typedef unsigned u32x2 __attribute__((ext_vector_type(2)));

struct Route { bf16_t* base; int ldc; int col; };
struct RouterSimple { bf16_t* O; int ldc; __device__ __forceinline__ Route operator()(int pn) const { return Route{O, ldc, pn * BM}; } };
struct RouterGm { bf16_t* U; bf16_t* V; __device__ __forceinline__ Route operator()(int pn) const { return pn < 8 ? Route{U, 2048, pn * BM} : Route{V, 2048, (pn - 8) * BM}; } };
template <int ACT, class Router> struct EpiStore {
    static constexpr bool PERM = true, AFTER_DRAIN = false;
    Router R;
    __device__ __forceinline__ void operator()(const f32x4 (&acc)[2][2][4][2], const Unit& u, int wr, int wc, int fr, int fq) const {
        const int row0 = u.pm * BM + wr * 64 + fr; const Route rt = R(u.pn);
        const int col0 = rt.col + wc * 32 + 8 * fq;
#pragma unroll
        for (int ai = 0; ai < 2; ++ai)
#pragma unroll
            for (int m = 0; m < 4; ++m) { bf16_t* rowp = rt.base + (size_t)(row0 + ai * HALF + m * 16) * rt.ldc + col0;
#pragma unroll
                for (int bj = 0; bj < 2; ++bj) { f32x4 v0 = acc[ai][bj][m][0], v1 = acc[ai][bj][m][1];
                    if (ACT == 1) { f32x2 a = gelu_pk((f32x2){v0[0], v0[1]}), b = gelu_pk((f32x2){v0[2], v0[3]}), c = gelu_pk((f32x2){v1[0], v1[1]}), d = gelu_pk((f32x2){v1[2], v1[3]});
                        v0 = (f32x4){a.x, a.y, b.x, b.y}; v1 = (f32x4){c.x, c.y, d.x, d.y}; }
                    u32x4 w; w.x = cvt_pk_bf16(v0[0], v0[1]); w.y = cvt_pk_bf16(v0[2], v0[3]); w.z = cvt_pk_bf16(v1[0], v1[1]); w.w = cvt_pk_bf16(v1[2], v1[3]);
                    *(u32x4*)(rowp + bj * HALF) = w; } }
    }
};
struct EpiGmIn {
    static constexpr bool PERM = true, AFTER_DRAIN = false;
    bf16_t* U; bf16_t* V; float* STATS;
    __device__ __forceinline__ void operator()(const f32x4 (&acc)[2][2][4][2], const Unit& u, int wr, int wc, int fr, int fq) const {
        const int row0 = u.pm * BM + wr * 64 + fr; const bool isv = u.pn >= 8;
        bf16_t* base = isv ? V : U; const int col0 = (isv ? u.pn - 8 : u.pn) * BM + wc * 32 + 8 * fq;
#pragma unroll
        for (int ai = 0; ai < 2; ++ai)
#pragma unroll
            for (int m = 0; m < 4; ++m) { const int row = row0 + ai * HALF + m * 16; bf16_t* rowp = base + (size_t)row * 2048 + col0; float s = 0.f, q = 0.f;
#pragma unroll
                for (int bj = 0; bj < 2; ++bj) { f32x4 v0 = acc[ai][bj][m][0], v1 = acc[ai][bj][m][1];
                    f32x2 a = gelu_pk((f32x2){v0[0], v0[1]}), b = gelu_pk((f32x2){v0[2], v0[3]}), c = gelu_pk((f32x2){v1[0], v1[1]}), d = gelu_pk((f32x2){v1[2], v1[3]});
                    u32x4 w; w.x = cvt_pk_bf16(a.x, a.y); w.y = cvt_pk_bf16(b.x, b.y); w.z = cvt_pk_bf16(c.x, c.y); w.w = cvt_pk_bf16(d.x, d.y);
                    *(u32x4*)(rowp + bj * HALF) = w;
                    s += ((a.x + a.y) + (b.x + b.y)) + ((c.x + c.y) + (d.x + d.y));
                    q += ((a.x * a.x + a.y * a.y) + (b.x * b.x + b.y * b.y)) + ((c.x * c.x + c.y * c.y) + (d.x * d.x + d.y * d.y)); }
                if (isv) { s += __shfl_xor(s, 16); s += __shfl_xor(s, 32); q += __shfl_xor(q, 16); q += __shfl_xor(q, 32);
                    if (fq == 0) { float* sp = STATS + (((size_t)row * 8 + (u.pn - 8)) * 4 + wc) * 2; sp[0] = s; sp[1] = q; } } }
    }
};
struct EpiSwiglu {
    static constexpr bool PERM = true, AFTER_DRAIN = false;
    bf16_t* O;
    __device__ __forceinline__ void operator()(const f32x4 (&acc)[2][2][4][2], const Unit& u, int wr, int wc, int fr, int fq) const {
        const int row0 = u.pm * BM + wr * 64 + fr; const int col0 = u.pn * HALF + wc * 32 + 8 * fq;
#pragma unroll
        for (int ai = 0; ai < 2; ++ai)
#pragma unroll
            for (int m = 0; m < 4; ++m) { bf16_t* rowp = O + (size_t)(row0 + ai * HALF + m * 16) * 2816 + col0;
                const f32x4 g0 = acc[ai][0][m][0], g1 = acc[ai][0][m][1], u0 = acc[ai][1][m][0], u1 = acc[ai][1][m][1];
                u32x4 w; w.x = cvt_pk_bf16(silu_f(g0[0]) * u0[0], silu_f(g0[1]) * u0[1]); w.y = cvt_pk_bf16(silu_f(g0[2]) * u0[2], silu_f(g0[3]) * u0[3]);
                w.z = cvt_pk_bf16(silu_f(g1[0]) * u1[0], silu_f(g1[1]) * u1[1]); w.w = cvt_pk_bf16(silu_f(g1[2]) * u1[2], silu_f(g1[3]) * u1[3]);
                *(u32x4*)rowp = w; }
    }
};
struct EpiResid {
    static constexpr bool PERM = false, AFTER_DRAIN = false;
    float* X; const float* gate_lat; const float* gate_ctx; int ctx_tile;
    __device__ __forceinline__ void operator()(const f32x4 (&acc)[2][2][4][2], const Unit& u, int wr, int wc, int fr, int fq) const {
        const int row0 = u.pm * BM + wr * 64 + fr; const int col0 = u.pn * BM + wc * 32 + 4 * fq;
        const float* gate = (ctx_tile && u.pm == 0) ? gate_ctx : gate_lat;
        f32x4 gv[2][2];
#pragma unroll
        for (int bj = 0; bj < 2; ++bj)
#pragma unroll
            for (int n = 0; n < 2; ++n) gv[bj][n] = *(const f32x4*)(gate + col0 + bj * HALF + 16 * n);
#pragma unroll
        for (int ai = 0; ai < 2; ++ai)
#pragma unroll
            for (int m = 0; m < 4; ++m) { float* xrow = X + (size_t)(row0 + ai * HALF + m * 16) * 1024 + col0;
#pragma unroll
                for (int bj = 0; bj < 2; ++bj)
#pragma unroll
                    for (int n = 0; n < 2; ++n) { f32x4* p = (f32x4*)(xrow + bj * HALF + 16 * n); *p = *p + gv[bj][n] * acc[ai][bj][m][n]; } }
    }
};
struct SplitKOrder {
    int nN, nks, G, c;
    __host__ __device__ void init(int N, int nks_, int G_, int c_) { nN = N / BM; nks = nks_; G = G_; c = c_; }
    __host__ __device__ bool next(int i, Unit& u) const { const long L = (long)i * G + c; if (L >= (long)nN * nks) return false; u.pm = 0; u.pn = (int)(L % nN); u.kz = (int)(L / nN); return true; }
    __device__ __forceinline__ void a_ready(const Unit&) const {}
    __device__ __forceinline__ void done(const Unit&) const {}
};
struct EpiPartial {
    static constexpr bool PERM = false, AFTER_DRAIN = false;
    float* P;
    __device__ __forceinline__ void operator()(const f32x4 (&acc)[2][2][4][2], const Unit& u, int wr, int wc, int fr, int fq) const {
        const int row0 = wr * 64 + fr; const int col0 = u.pn * BM + wc * 32 + 4 * fq;
#pragma unroll
        for (int ai = 0; ai < 2; ++ai)
#pragma unroll
            for (int m = 0; m < 4; ++m) { float* prow = P + ((size_t)u.kz * 256 + row0 + ai * HALF + m * 16) * 1024 + col0;
#pragma unroll
                for (int bj = 0; bj < 2; ++bj)
#pragma unroll
                    for (int n = 0; n < 2; ++n) *(f32x4*)(prow + bj * HALF + 16 * n) = acc[ai][bj][m][n]; }
    }
};
struct EpiSsdIn {
    static constexpr bool PERM = true, AFTER_DRAIN = false;
    bf16_t* Z; bf16_t* XBC; float* DT; bf16_t* HALO;
    __device__ __forceinline__ void operator()(const f32x4 (&acc)[2][2][4][2], const Unit& u, int wr, int wc, int fr, int fq) const {
        const int row0 = u.pm * BM + wr * 64 + fr; const int pn = u.pn;
        if (pn < 20) {
            bf16_t* base = pn < 8 ? Z : XBC; const int ldc = pn < 8 ? 2048 : 3072; const int col0 = (pn < 8 ? pn : pn - 8) * BM + wc * 32 + 8 * fq;
#pragma unroll
            for (int ai = 0; ai < 2; ++ai)
#pragma unroll
                for (int m = 0; m < 4; ++m) { const int row = row0 + ai * HALF + m * 16; bf16_t* rowp = base + (size_t)row * ldc + col0; const int rl = row & 31;
#pragma unroll
                    for (int bj = 0; bj < 2; ++bj) { const f32x4 v0 = acc[ai][bj][m][0], v1 = acc[ai][bj][m][1];
                        u32x4 w; w.x = cvt_pk_bf16(v0[0], v0[1]); w.y = cvt_pk_bf16(v0[2], v0[3]); w.z = cvt_pk_bf16(v1[0], v1[1]); w.w = cvt_pk_bf16(v1[2], v1[3]);
                        *(u32x4*)(rowp + bj * HALF) = w;
                        if (pn >= 8 && (rl == 0 || rl == 31)) *(u32x4*)(HALO + ((size_t)(row >> 5) * 2 + (rl == 31 ? 1 : 0)) * 3072 + col0 + bj * HALF) = w; } }
        } else if (wc < 2) {
#pragma unroll
            for (int ai = 0; ai < 2; ++ai)
#pragma unroll
                for (int m = 0; m < 4; ++m) { float* rowp = DT + (size_t)(row0 + ai * HALF + m * 16) * 64 + wc * 32 + 8 * fq;
                    *(f32x4*)rowp = acc[ai][0][m][0]; *(f32x4*)(rowp + 4) = acc[ai][0][m][1]; }
        }
    }
};
template <class Epi, class Sched, bool ALIGN_EPI = false, bool SP2 = false>
__device__ __forceinline__ void gemm_phase(PG8_LAS unsigned char* lds, const Gemm g, const Sched& S, const Epi& E) {
    const int tid = TIDX(), wid = __builtin_amdgcn_readfirstlane(tid >> 6), lane = tid & 63, wr = wid >> 2, wc = wid & 3, fr = lane & 15, fq = lane >> 4;
    const int K = g.K, nt = g.kloop / BK; const size_t kzb = (size_t)g.kloop * 2;
    unsigned voffA[2], voffB[2];
#pragma unroll
    for (int i = 0; i < 2; ++i) { int R, C; stage_rc(tid * 16 + i * 8192, R, C); const int Rb = Epi::PERM ? ((R & ~31) + perm32(R & 31)) : R;
        voffA[i] = (unsigned)(R * K + C) * 2u; voffB[i] = (unsigned)(Rb * K + C) * 2u; }
    const size_t kstep = (size_t)(BK * 2);
    const size_t hstep = (size_t)HALF * K * 2;
    const size_t tstep = 2 * hstep;
    const unsigned ldsw = (unsigned)wid * 1024u;
    const int aoff = lds_byte(wr * 64 + fr, fq * 8), boff = lds_byte(wc * 32 + fr, fq * 8);
#define PG8_SA(b, h) (((b) * 2 + (h)) * HTB)
#define PG8_SB(b, h) ((4 + (b) * 2 + (h)) * HTB)
#define PG8_STAGE(bufoff, gbase, voff) do { _Pragma("unroll") for (int _i = 0; _i < 2; ++_i) \
        __builtin_amdgcn_global_load_lds((const unsigned*)((const char*)(gbase) + (voff)[_i]), (PG8_LAS unsigned*)(lds + (bufoff) + ldsw + _i * 8192), 16, 0, 0); } while (0)
#define PG8_LDA(dst, b, h) do { _Pragma("unroll") for (int m = 0; m < 4; ++m) _Pragma("unroll") for (int k = 0; k < 2; ++k) dst[m][k] = *(const PG8_LAS bf16x8*)(lds + PG8_SA(b, h) + aoff + m * 2048 + k * 1024); } while (0)
#define PG8_LDB(dst, b, h) do { _Pragma("unroll") for (int n = 0; n < 2; ++n) _Pragma("unroll") for (int k = 0; k < 2; ++k) dst[n][k] = *(const PG8_LAS bf16x8*)(lds + PG8_SB(b, h) + boff + n * 2048 + k * 1024); } while (0)
#define PG8_MMA(ai, bj, At, Bt) do { __builtin_amdgcn_s_setprio(1); _Pragma("unroll") for (int m = 0; m < 4; ++m) _Pragma("unroll") for (int n = 0; n < 2; ++n) _Pragma("unroll") for (int k = 0; k < 2; ++k) \
        acc[ai][bj][m][n] = __builtin_amdgcn_mfma_f32_16x16x32_bf16(Bt[n][k], At[m][k], acc[ai][bj][m][n], 0, 0, 0); __builtin_amdgcn_s_setprio(0); } while (0)
#define PG8_WAIT_V(n) asm volatile("s_waitcnt vmcnt(" #n ")" ::: "memory")
#define PG8_WAIT_L(n) asm volatile("s_waitcnt lgkmcnt(" #n ")" ::: "memory")
#define PG8_BAR __builtin_amdgcn_s_barrier()
#define PG8_SCHED __builtin_amdgcn_sched_barrier(0)
    Unit cur, nxt; int ui = 0;
    if (!S.next(0, cur)) return;
    f32x4 acc[2][2][4][2];
#pragma unroll
    for (int a = 0; a < 2; ++a)
#pragma unroll
        for (int b = 0; b < 2; ++b)
#pragma unroll
            for (int m = 0; m < 4; ++m)
#pragma unroll
                for (int n = 0; n < 2; ++n) acc[a][b][m][n] = (f32x4){0.f, 0.f, 0.f, 0.f};
    bf16x8 At[4][2], B0[2][2], B1[2][2];
    const char* cA = (const char*)g.A + (size_t)cur.pm * tstep + (size_t)cur.kz * kzb; const char* cB = (const char*)g.Bt + (size_t)cur.pn * tstep + (size_t)cur.kz * kzb;
    S.a_ready(cur);
    if constexpr (SP2) {
        PG8_STAGE(PG8_SB(0, 0), cB, voffB); PG8_STAGE(PG8_SB(0, 1), cB + hstep, voffB); PG8_STAGE(PG8_SA(0, 0), cA, voffA); PG8_STAGE(PG8_SA(0, 1), cA + hstep, voffA);
        if (wr == 1) PG8_BAR;
        PG8_WAIT_V(2); PG8_BAR;
        PG8_STAGE(PG8_SB(1, 0), cB + kstep, voffB); PG8_STAGE(PG8_SA(1, 0), cA + kstep, voffA); PG8_STAGE(PG8_SB(1, 1), cB + hstep + kstep, voffB);
        PG8_WAIT_V(6); PG8_BAR;
    } else {
        PG8_STAGE(PG8_SB(0, 0), cB, voffB); PG8_STAGE(PG8_SA(0, 0), cA, voffA); PG8_STAGE(PG8_SB(0, 1), cB + hstep, voffB); PG8_STAGE(PG8_SA(0, 1), cA + hstep, voffA);
        if (wr == 1) PG8_BAR;
        PG8_WAIT_V(4); PG8_BAR;
        PG8_STAGE(PG8_SB(1, 0), cB + kstep, voffB); PG8_STAGE(PG8_SA(1, 0), cA + kstep, voffA); PG8_STAGE(PG8_SB(1, 1), cB + hstep + kstep, voffB);
        PG8_WAIT_V(6); PG8_BAR;
    }
    for (;;) {
        const bool has_next = S.next(ui + 1, nxt);
        const char* nA = has_next ? (const char*)g.A + (size_t)nxt.pm * tstep + (size_t)nxt.kz * kzb : cA; const char* nB = has_next ? (const char*)g.Bt + (size_t)nxt.pn * tstep + (size_t)nxt.kz * kzb : cB;
        for (int t = 0; t < nt; t += 2) {
            const bool last = (t == nt - 2);
            const char* a1 = cA + (size_t)(t + 1) * kstep;
            const char* a2 = last ? nA : cA + (size_t)(t + 2) * kstep; const char* b2 = last ? nB : cB + (size_t)(t + 2) * kstep;
            const char* a3 = a2 + kstep; const char* b3 = b2 + kstep;
            if (last && has_next) S.a_ready(nxt);
            if constexpr (SP2) {
            PG8_LDB(B0, 0, 0); PG8_LDB(B1, 0, 1); PG8_SCHED; PG8_LDA(At, 0, 0); PG8_STAGE(PG8_SA(1, 1), a1 + hstep, voffA);
            PG8_WAIT_V(8); PG8_WAIT_L(0); PG8_BAR; PG8_MMA(0, 0, At, B0); PG8_MMA(0, 1, At, B1); PG8_BAR; PG8_SCHED;
            PG8_LDA(At, 0, 1); PG8_STAGE(PG8_SB(0, 0), b2, voffB); PG8_STAGE(PG8_SB(0, 1), b2 + hstep, voffB); PG8_STAGE(PG8_SA(0, 0), a2, voffA);
            PG8_WAIT_V(8); PG8_WAIT_L(0); PG8_BAR; PG8_MMA(1, 0, At, B0); PG8_MMA(1, 1, At, B1); PG8_BAR; PG8_SCHED;
            PG8_LDB(B0, 1, 0); PG8_LDB(B1, 1, 1); PG8_SCHED; PG8_LDA(At, 1, 0); PG8_STAGE(PG8_SA(0, 1), a2 + hstep, voffA);
            PG8_WAIT_V(8); PG8_WAIT_L(0); PG8_BAR; PG8_MMA(0, 0, At, B0); PG8_MMA(0, 1, At, B1); PG8_BAR; PG8_SCHED;
            PG8_LDA(At, 1, 1); PG8_STAGE(PG8_SB(1, 0), b3, voffB); PG8_STAGE(PG8_SB(1, 1), b3 + hstep, voffB); PG8_STAGE(PG8_SA(1, 0), a3, voffA);
            PG8_WAIT_V(8); PG8_WAIT_L(0); PG8_BAR; PG8_MMA(1, 0, At, B0); PG8_MMA(1, 1, At, B1); PG8_BAR; PG8_SCHED;
            } else {
            PG8_LDB(B0, 0, 0); PG8_SCHED; PG8_LDA(At, 0, 0); PG8_STAGE(PG8_SA(1, 1), a1 + hstep, voffA);
            PG8_WAIT_L(8); PG8_BAR; PG8_WAIT_L(0); PG8_MMA(0, 0, At, B0); PG8_BAR; PG8_SCHED;
            PG8_LDB(B1, 0, 1); PG8_STAGE(PG8_SB(0, 0), b2, voffB);
            PG8_BAR; PG8_WAIT_L(0); PG8_MMA(0, 1, At, B1); PG8_BAR;
            PG8_LDA(At, 0, 1); PG8_STAGE(PG8_SA(0, 0), a2, voffA);
            PG8_BAR; PG8_WAIT_L(0); PG8_MMA(1, 0, At, B0); PG8_BAR; PG8_SCHED;
            PG8_STAGE(PG8_SB(0, 1), b2 + hstep, voffB);
            PG8_WAIT_V(6); PG8_BAR; PG8_MMA(1, 1, At, B1); PG8_BAR;
            PG8_LDB(B0, 1, 0); PG8_SCHED; PG8_LDA(At, 1, 0); PG8_STAGE(PG8_SA(0, 1), a2 + hstep, voffA);
            PG8_WAIT_L(8); PG8_BAR; PG8_WAIT_L(0); PG8_MMA(0, 0, At, B0); PG8_BAR; PG8_SCHED;
            PG8_LDB(B1, 1, 1); PG8_STAGE(PG8_SB(1, 0), b3, voffB);
            PG8_BAR; PG8_WAIT_L(0); PG8_MMA(0, 1, At, B1); PG8_BAR;
            PG8_LDA(At, 1, 1); PG8_STAGE(PG8_SA(1, 0), a3, voffA);
            PG8_BAR; PG8_WAIT_L(0); PG8_MMA(1, 0, At, B0); PG8_BAR; PG8_SCHED;
            PG8_STAGE(PG8_SB(1, 1), b3 + hstep, voffB);
            PG8_WAIT_V(6); PG8_BAR; PG8_MMA(1, 1, At, B1); PG8_BAR;
            }
        }
        if constexpr (ALIGN_EPI) { if (wr == 0) PG8_BAR; }
        if constexpr (!Epi::AFTER_DRAIN) { E(acc, cur, wr, wc, fr, fq); S.done(cur); }
        if (!has_next) break;
#pragma unroll
        for (int a = 0; a < 2; ++a)
#pragma unroll
            for (int b = 0; b < 2; ++b)
#pragma unroll
                for (int m = 0; m < 4; ++m)
#pragma unroll
                    for (int n = 0; n < 2; ++n) acc[a][b][m][n] = (f32x4){0.f, 0.f, 0.f, 0.f};
        cur = nxt; cA = nA; cB = nB; ++ui;
        if constexpr (ALIGN_EPI) { if (wr == 1) PG8_BAR; }
    }
    PG8_WAIT_V(0);
    if constexpr (!ALIGN_EPI) { if (wr == 0) PG8_BAR; }
    PG8_BAR;
    if constexpr (Epi::AFTER_DRAIN) { E.fused(acc, cur, wr, wc, fr, fq, lds, wid, lane); S.done(cur); }
#undef PG8_SA
#undef PG8_SB
#undef PG8_STAGE
#undef PG8_LDA
#undef PG8_LDB
#undef PG8_MMA
#undef PG8_WAIT_V
#undef PG8_WAIT_L
#undef PG8_BAR
#undef PG8_SCHED
}
}
#include <hip/hip_bf16.h>
#include <cmath>
namespace attn_body {
using bf16=__hip_bfloat16;
using bf16x8=__attribute__((ext_vector_type(8)))short;
using s16x4=__attribute__((ext_vector_type(4)))short;
using f32x16=__attribute__((ext_vector_type(16)))float;
using u32x4=__attribute__((ext_vector_type(4)))unsigned;
constexpr int NHEAD=16,D=64,QP=1024,KP=256;
constexpr int NW=8,QBLK=32,QB=QBLK*NW,KVBLK=64;
constexpr int ATTN_UNIT_ROWS=QB;
__device__ __forceinline__ int crow(int r,int hi){return (r&3)+8*(r>>2)+4*hi;}
#define SBAR() __builtin_amdgcn_sched_barrier(0)
__device__ __forceinline__ void cmask(f32x16&p0,f32x16&p1,int jb,int qrel,int hi){
  const float NEG=-INFINITY; int kb=64*jb+4*hi;
  #pragma unroll
  for(int r=0;r<16;++r){int kv=kb+(r&3)+8*(r>>2); if(kv>qrel)p0[r]=NEG; if(kv+32>qrel)p1[r]=NEG;}
}

constexpr int NSLOT=3, SLOTB=8192;
constexpr int LDS_K=0, LDS_V=NSLOT*SLOTB, LDS_WS=2*NSLOT*SLOTB, LDS_OST=LDS_WS+NW*64*4, LDS_BYTES=LDS_OST+NW*4096;
constexpr float C2=0.125f*1.4426950408889634f;
__device__ __forceinline__ void glds16(const void*gsrc,unsigned lds_dst){unsigned keep;
  asm volatile("s_mov_b32 %0, m0\n\ts_mov_b32 m0, %2\n\ts_nop 0\n\tglobal_load_lds_dwordx4 %1, off\n\ts_mov_b32 m0, %0":"=&s"(keep):"v"(gsrc),"s"(lds_dst):"memory");}
__device__ __forceinline__ float max3f(float a,float b,float c){float r;asm("v_max3_f32 %0, %1, %2, %3":"=v"(r):"v"(a),"v"(b),"v"(c));return r;}
__device__ __forceinline__ float max2f(float a,float b){float r;asm("v_max_f32_e32 %0, %1, %2":"=v"(r):"v"(a),"v"(b));return r;}
__device__ __forceinline__ float fadd_s(float a,float b){float r;asm("v_add_f32_e32 %0, %1, %2":"=v"(r):"v"(a),"v"(b));return r;}
__device__ __forceinline__ float fsub_s(float a,float b){float r;asm("v_sub_f32_e32 %0, %1, %2":"=v"(r):"v"(a),"v"(b));return r;}
typedef float f32x2_t __attribute__((ext_vector_type(2))); typedef __bf16 bf16x2_t __attribute__((ext_vector_type(2)));
__device__ __forceinline__ unsigned cvtpk_s(float lo,float hi){f32x2_t v={lo,hi};bf16x2_t b=__builtin_convertvector(v,bf16x2_t);return __builtin_bit_cast(unsigned,b);}
#define WAIT_BAR(N) asm volatile("s_waitcnt vmcnt(" #N ") lgkmcnt(0)\n\ts_barrier":::"memory")

__device__ __forceinline__ void qkt(f32x16&p0,f32x16&p1,const char*Kslot,const bf16x8*qr,const f32x16&negm,int r32,int hi){
  const char*kb=Kslot+hi*1024+r32*16;
  #pragma unroll
  for(int d0=0;d0<4;++d0){
    const bf16x8 b0=*reinterpret_cast<const bf16x8*>(kb+d0*2048);
    const bf16x8 b1=*reinterpret_cast<const bf16x8*>(kb+d0*2048+512);
    if(d0==0){p0=__builtin_amdgcn_mfma_f32_32x32x16_bf16(b0,qr[0],negm,0,0,0);p1=__builtin_amdgcn_mfma_f32_32x32x16_bf16(b1,qr[0],negm,0,0,0);}
    else{p0=__builtin_amdgcn_mfma_f32_32x32x16_bf16(b0,qr[d0],p0,0,0,0);p1=__builtin_amdgcn_mfma_f32_32x32x16_bf16(b1,qr[d0],p1,0,0,0);}}
}
typedef __attribute__((address_space(3))) const char* lds_cptr;
typedef short v4i16_t __attribute__((ext_vector_type(4)));
__device__ __forceinline__ void kload8(bf16x8*kf,lds_cptr kp){
  kf[0]=*(const __attribute__((address_space(3))) bf16x8*)(kp);      kf[1]=*(const __attribute__((address_space(3))) bf16x8*)(kp+512);
  kf[2]=*(const __attribute__((address_space(3))) bf16x8*)(kp+2048); kf[3]=*(const __attribute__((address_space(3))) bf16x8*)(kp+2560);
  kf[4]=*(const __attribute__((address_space(3))) bf16x8*)(kp+4096); kf[5]=*(const __attribute__((address_space(3))) bf16x8*)(kp+4608);
  kf[6]=*(const __attribute__((address_space(3))) bf16x8*)(kp+6144); kf[7]=*(const __attribute__((address_space(3))) bf16x8*)(kp+6656);
}
__device__ __forceinline__ void kload2(bf16x8*kf,lds_cptr kp,int j){ kf[2*j]=*(const __attribute__((address_space(3))) bf16x8*)(kp+j*2048); kf[2*j+1]=*(const __attribute__((address_space(3))) bf16x8*)(kp+j*2048+512); }
__device__ __forceinline__ s16x4 vtr(lds_cptr p){ return __builtin_bit_cast(s16x4,__builtin_amdgcn_ds_read_tr16_b64_v4i16((__attribute__((address_space(3))) v4i16_t*)p)); }
__device__ __forceinline__ float rowmax(const f32x16&p0,const f32x16&p1){
  float a=max3f(p0[0],p0[1],p1[0]),b=max3f(p0[2],p0[3],p1[1]);a=max3f(a,p1[2],p1[3]);
  #pragma unroll
  for(int r=4;r<16;r+=4){a=max3f(a,p0[r],p0[r+1]);b=max3f(b,p0[r+2],p0[r+3]);a=max3f(a,p1[r],p1[r+1]);b=max3f(b,p1[r+2],p1[r+3]);}
  const float m=max2f(a,b);
  auto rr=__builtin_amdgcn_permlane32_swap(__float_as_uint(m),__float_as_uint(m),false,false);
  return max2f(__uint_as_float(rr[0]),__uint_as_float(rr[1]));
}
__device__ __forceinline__ void pv(f32x16*o,int vb,bf16x8 pa0,bf16x8 pa1,bf16x8 pa2,bf16x8 pa3){
  #pragma unroll
  for(int d0=0;d0<2;++d0){s16x4 lo[4],hi[4];
    #pragma unroll
    for(int ks=0;ks<4;++ks){
      asm volatile("ds_read_b64_tr_b16 %0,%1 offset:%c2":"=&v"(lo[ks]):"v"(vb),"i"(d0*4096+ks*1024):"memory");
      asm volatile("ds_read_b64_tr_b16 %0,%1 offset:%c2":"=&v"(hi[ks]):"v"(vb),"i"(d0*4096+ks*1024+512):"memory");}
    asm volatile("s_waitcnt lgkmcnt(0)":::"memory");SBAR();
    #define PK(k) (bf16x8){lo[k][0],lo[k][1],lo[k][2],lo[k][3],hi[k][0],hi[k][1],hi[k][2],hi[k][3]}
    o[d0]=__builtin_amdgcn_mfma_f32_32x32x16_bf16(pa0,PK(0),o[d0],0,0,0);
    o[d0]=__builtin_amdgcn_mfma_f32_32x32x16_bf16(pa1,PK(1),o[d0],0,0,0);
    o[d0]=__builtin_amdgcn_mfma_f32_32x32x16_bf16(pa2,PK(2),o[d0],0,0,0);
    o[d0]=__builtin_amdgcn_mfma_f32_32x32x16_bf16(pa3,PK(3),o[d0],0,0,0);
    #undef PK
  }
}

#ifndef ATTN_STORE16
#define ATTN_STORE16(p,v) (*(u32x4*)(p)=(v))
#endif
template<int THRL> __device__ __forceinline__ void attn_unit(int qrow0,int h,int NT,const bf16*Q,const bf16*__restrict__ K,const bf16*__restrict__ V,bf16*O,char*shm){
  const int tid=TIDX(),lane=tid&63,r32=lane&31,hi=lane>>5; const int wid=__builtin_amdgcn_readfirstlane(tid>>6);
  const bf16*Qw=Q+(long)(qrow0+wid*QBLK)*QP+h*D;
  const bf16*Kh=K+(h>>2)*D,*Vh=V+(h>>2)*D;
  const unsigned lds0=(unsigned)(uintptr_t)shm;
  float*wsf=(float*)(shm+LDS_WS)+wid*64;
  const bf16*ksrc=Kh+(long)lane*KP+wid*8;
  const bf16*vsrc=Vh+(long)(16*(wid&3)+(lane>>2))*KP+(wid>>2)*32+(lane&3)*8;
  const unsigned kdst=lds0+LDS_K+wid*1024, vdst=lds0+LDS_V+wid*1024;
  #define DMA_K(t,slot) glds16(ksrc+(long)(t)*KVBLK*KP,(unsigned)__builtin_amdgcn_readfirstlane(kdst+(slot)))
  #define DMA_V(t,slot) glds16(vsrc+(long)(t)*KVBLK*KP,(unsigned)__builtin_amdgcn_readfirstlane(vdst+(slot)))
  const int vb0=(int)(lds0+LDS_V)+((lane>>4)&1)*32+(lane&3)*8+(4*hi+((lane&15)>>2))*64;
  const char*Kbase=shm+LDS_K; bf16x8 kf[8];
  const lds_cptr shm3=(lds_cptr)shm; const lds_cptr kp0=shm3+LDS_K+hi*1024+r32*16; const lds_cptr vp0=shm3+LDS_V+((lane>>4)&1)*32+(lane&3)*8+(4*hi+((lane&15)>>2))*64;
  DMA_K(0,0);DMA_V(0,0);DMA_K(1,SLOTB);
  bf16x8 qr[4];
  #pragma unroll
  for(int d0=0;d0<4;++d0)qr[d0]=*reinterpret_cast<const bf16x8*>(&Qw[(long)r32*QP+d0*16+hi*8]);
  float mhat=0.f,l_reg=0.f;f32x16 o[2];o[0]=f32x16{};o[1]=f32x16{};f32x16 negm=f32x16{};asm volatile("":"+v"(negm));
  #define CMASK(P0,P1,t) do{}while(0)
  bool resc=false;
  #define START(P0,P1) do{ const float rm=rowmax(P0,P1); resc=false; \
    { const float dl=rm; mhat=fadd_s(mhat,dl); \
      _Pragma("unroll") for(int r=0;r<16;++r){P0[r]=fsub_s(P0[r],dl);P1[r]=fsub_s(P1[r],dl);} \
      _Pragma("unroll") for(int r=0;r<16;++r)negm[r]=-mhat; asm volatile("":"+v"(negm)); } \
    _Pragma("unroll") for(int r=0;r<16;++r)P0[r]=__builtin_amdgcn_exp2f(P0[r]); }while(0)
  #define RESC() do{ if(resc){ asm volatile("s_waitcnt lgkmcnt(0)":::"memory"); \
      _Pragma("unroll") for(int d_=0;d_<2;++d_) _Pragma("unroll") for(int r=0;r<16;++r)o[d_][r]*=wsf[crow(r,hi)]; } }while(0)
  f32x16 pA0,pA1,pB0,pB1;
  int sl_prev=0,sl_cur=0,sl_next=SLOTB;
  #define ROT() do{sl_prev=sl_cur;sl_cur=sl_next;sl_next=(sl_next==(NSLOT-1)*SLOTB)?0:sl_next+SLOTB;}while(0)
  DMA_K(2,2*SLOTB);
  WAIT_BAR(3);
  qkt(pA0,pA1,Kbase,qr,negm,r32,hi);asm volatile("s_nop 15\n\ts_nop 7":"+v"(pA0),"+v"(pA1));CMASK(pA0,pA1,0);
  START(pA0,pA1);
  _Pragma("unroll") for(int r=0;r<16;++r)pA1[r]=__builtin_amdgcn_exp2f(pA1[r]);
  WAIT_BAR(0);
  DMA_K(3,0);DMA_V(1,SLOTB);
  ROT();
  kload8(kf,kp0+sl_cur);
  WAIT_BAR(2);
  s16x4 vlo[8],vhi[8]; u32x4 pw0,pw1,pw2,pw3;
  #define PKW(P,B) cvtpk_s(P[B],P[B+1])
  #define PAF(k) __builtin_bit_cast(bf16x8,pw##k)
  #define VFR(i) (bf16x8){vlo[i][0],vlo[i][1],vlo[i][2],vlo[i][3],vhi[i][0],vhi[i][1],vhi[i][2],vhi[i][3]}
  #define PIN(x) asm volatile("":"+v"(x))
  #define MX3(a,b,c) __builtin_fmaxf(__builtin_fmaxf((a),(b)),(c))
  #define GAPA(MF,A0,A1,A2,A3,W0,W1,PW) do{ MF; sacc+=A0; sacc+=A1; sacc+=A2; sacc+=A3; PIN(sacc); W0; W1; PIN(PW); SBAR(); }while(0)
  #define EX(v) __builtin_amdgcn_exp2f(v)
  #define GAPB(MF,X,B) do{ MF; X[B]=EX(X[B]); X[B+1]=EX(X[B+1]); X[B+2]=EX(X[B+2]); X[B+3]=EX(X[B+3]); PIN(X); SBAR(); }while(0)
  #define VRD(i) do{ vlo[i]=vtr(vp_+(((i)>>2)*4096+((i)&3)*1024)); vhi[i]=vtr(vp_+(((i)>>2)*4096+((i)&3)*1024+512)); }while(0)
  #define KRD(G,j) do{ if(G){ kload2(kf,kp0+sl_next,j); SBAR(); } }while(0)
  #define STEP(C0,C1,P0,P1,t,GK,GV,GL) do{ SBAR(); \
    const lds_cptr vp_=vp0+sl_prev; \
    VRD(0); SBAR(); float sacc=(P0[0]+P0[1]); \
    GAPA(C0=__builtin_amdgcn_mfma_f32_32x32x16_bf16(kf[0],qr[0],negm,0,0,0), P0[2],P0[3],P0[4],P0[5],     pw0[0]=PKW(P0,0), pw0[1]=PKW(P0,2), pw0); \
    VRD(4); SBAR(); GAPA(C1=__builtin_amdgcn_mfma_f32_32x32x16_bf16(kf[1],qr[0],negm,0,0,0), P0[6],P0[7],P0[8],P0[9],     pw0[2]=PKW(P0,4), pw0[3]=PKW(P0,6), pw0); \
    VRD(1); SBAR(); GAPA(C0=__builtin_amdgcn_mfma_f32_32x32x16_bf16(kf[2],qr[1],C0,0,0,0),   P0[10],P0[11],P0[12],P0[13], pw1[0]=PKW(P0,8), pw1[1]=PKW(P0,10), pw1); \
    VRD(5); SBAR(); GAPA(C1=__builtin_amdgcn_mfma_f32_32x32x16_bf16(kf[3],qr[1],C1,0,0,0),   P0[14],P0[15],P1[0],P1[1],   pw1[2]=PKW(P0,12),pw1[3]=PKW(P0,14), pw1); \
    VRD(2); SBAR(); GAPA(C0=__builtin_amdgcn_mfma_f32_32x32x16_bf16(kf[4],qr[2],C0,0,0,0),   P1[2],P1[3],P1[4],P1[5],     pw2[0]=PKW(P1,0), pw2[1]=PKW(P1,2), pw2); \
    VRD(6); SBAR(); GAPA(C1=__builtin_amdgcn_mfma_f32_32x32x16_bf16(kf[5],qr[2],C1,0,0,0),   P1[6],P1[7],P1[8],P1[9],     pw2[2]=PKW(P1,4), pw2[3]=PKW(P1,6), pw2); \
    VRD(3); SBAR(); GAPA(C0=__builtin_amdgcn_mfma_f32_32x32x16_bf16(kf[6],qr[3],C0,0,0,0),   P1[10],P1[11],P1[12],P1[13], pw3[0]=PKW(P1,8), pw3[1]=PKW(P1,10), pw3); \
    VRD(7); SBAR(); GAPA(C1=__builtin_amdgcn_mfma_f32_32x32x16_bf16(kf[7],qr[3],C1,0,0,0),   P1[14],P1[15],0.f,0.f,       pw3[2]=PKW(P1,12),pw3[3]=PKW(P1,14), pw3); \
    l_reg+=sacc; \
    if(GK){DMA_K((t)+3,sl_cur);} if(GV){DMA_V((t)+1,sl_next);} \
    CMASK(C0,C1,t); \
    { float a=MX3(C0[0],C0[1],C1[0]),b=MX3(C0[2],C0[3],C1[1]); a=MX3(a,C1[2],C1[3]); \
      _Pragma("unroll") for(int r=4;r<16;r+=4){a=MX3(a,C0[r],C0[r+1]);b=MX3(b,C0[r+2],C0[r+3]);a=MX3(a,C1[r],C1[r+1]);b=MX3(b,C1[r+2],C1[r+3]);} \
      float rm=__builtin_fmaxf(a,b); { auto rr=__builtin_amdgcn_permlane32_swap(__float_as_uint(rm),__float_as_uint(rm),false,false); rm=__builtin_fmaxf(__uint_as_float(rr[0]),__uint_as_float(rr[1])); } \
      resc=false; \
      if(__builtin_expect(__any(rm>(float)THRL),0)){ const float dl=__builtin_fmaxf(rm,0.f); mhat+=dl; \
        _Pragma("unroll") for(int r=0;r<16;++r){C0[r]-=dl;C1[r]-=dl;} \
        _Pragma("unroll") for(int r=0;r<16;++r)negm[r]=-mhat; asm volatile("":"+v"(negm)); \
        const float f=__builtin_amdgcn_exp2f(-dl); l_reg*=f; if(hi==0)wsf[r32]=f; resc=true; } } \
    SBAR(); \
    GAPB(o[0]=__builtin_amdgcn_mfma_f32_32x32x16_bf16(PAF(0),VFR(0),o[0],0,0,0), C0,0); \
    GAPB(o[1]=__builtin_amdgcn_mfma_f32_32x32x16_bf16(PAF(0),VFR(4),o[1],0,0,0), C0,4); \
    KRD(GL,0); GAPB(o[0]=__builtin_amdgcn_mfma_f32_32x32x16_bf16(PAF(1),VFR(1),o[0],0,0,0), C0,8); \
    KRD(GL,1); GAPB(o[1]=__builtin_amdgcn_mfma_f32_32x32x16_bf16(PAF(1),VFR(5),o[1],0,0,0), C0,12); \
    KRD(GL,2); GAPB(o[0]=__builtin_amdgcn_mfma_f32_32x32x16_bf16(PAF(2),VFR(2),o[0],0,0,0), C1,0); \
    KRD(GL,3); GAPB(o[1]=__builtin_amdgcn_mfma_f32_32x32x16_bf16(PAF(2),VFR(6),o[1],0,0,0), C1,4); \
    GAPB(o[0]=__builtin_amdgcn_mfma_f32_32x32x16_bf16(PAF(3),VFR(3),o[0],0,0,0), C1,8); \
    GAPB(o[1]=__builtin_amdgcn_mfma_f32_32x32x16_bf16(PAF(3),VFR(7),o[1],0,0,0), C1,12); \
    }while(0)
  int t=1;
  #undef CMASK
  #define CMASK(P0,P1,t) do{}while(0)
  for(;t+5<NT;t+=2){
    STEP(pB0,pB1,pA0,pA1,t,true,true,true);     WAIT_BAR(2); RESC(); ROT();
    STEP(pA0,pA1,pB0,pB1,t+1,true,true,true);   WAIT_BAR(2); RESC(); ROT();
  }
  #undef CMASK
  #define CMASK(P0,P1,t) do{}while(0)
  #define ENDW(tt) do{ if((tt)+3<NT){WAIT_BAR(2);} else if((tt)+2<NT){WAIT_BAR(1);} else {WAIT_BAR(0);} }while(0)
  for(;t+1<NT;t+=2){
    STEP(pB0,pB1,pA0,pA1,t,(t+3<NT),(t+1<NT),(t+1<NT));       ENDW(t);   RESC(); ROT();
    STEP(pA0,pA1,pB0,pB1,t+1,(t+4<NT),(t+2<NT),(t+2<NT));     ENDW(t+1); RESC(); ROT();
  }
  STEP(pB0,pB1,pA0,pA1,NT-1,false,false,false); RESC();
  { float sacc=pB0[0]+pB0[1]; _Pragma("unroll") for(int r=2;r<16;++r)sacc+=pB0[r]; _Pragma("unroll") for(int r=0;r<16;++r)sacc+=pB1[r]; l_reg+=sacc;
    pw0=(u32x4){PKW(pB0,0),PKW(pB0,2),PKW(pB0,4),PKW(pB0,6)};pw1=(u32x4){PKW(pB0,8),PKW(pB0,10),PKW(pB0,12),PKW(pB0,14)};pw2=(u32x4){PKW(pB1,0),PKW(pB1,2),PKW(pB1,4),PKW(pB1,6)};pw3=(u32x4){PKW(pB1,8),PKW(pB1,10),PKW(pB1,12),PKW(pB1,14)};
    SBAR(); pv(o,vb0+sl_cur,PAF(0),PAF(1),PAF(2),PAF(3)); }
  #undef PKW
  #undef PAF
  #undef VFR
  #undef PIN
  #undef MX3
  #undef GAPA
  #undef GAPB
  #undef EX
  #undef VRD
  #undef KRD
  #undef STEP
  #undef ENDW
  {auto rr=__builtin_amdgcn_permlane32_swap(__float_as_uint(l_reg),__float_as_uint(l_reg),false,false);l_reg=__uint_as_float(rr[0])+__uint_as_float(rr[1]);}
  if(hi==0)wsf[32+r32]=l_reg;asm volatile("s_waitcnt lgkmcnt(0)":::"memory");
  float rli[16];
  #pragma unroll
  for(int r=0;r<16;++r)rli[r]=__builtin_amdgcn_rcpf(wsf[32+crow(r,hi)]);
  bf16*Ow=O+(long)(qrow0+wid*QBLK)*QP+h*D;
  { bf16*stg=(bf16*)(shm+LDS_OST)+wid*2048;
    #pragma unroll
    for(int r=0;r<16;++r){const int orow=crow(r,hi);
      #pragma unroll
      for(int d0=0;d0<2;++d0)stg[orow*64+d0*32+r32]=__float2bfloat16(o[d0][r]*rli[r]);}
    asm volatile("s_waitcnt lgkmcnt(0)":::"memory");
    #pragma unroll
    for(int i=0;i<4;++i){const int row=i*8+(lane>>3),ch=lane&7; const u32x4 v=*(const u32x4*)(stg+row*64+ch*8); ATTN_STORE16(Ow+(long)row*QP+ch*8,v);} }
  asm volatile("s_waitcnt lgkmcnt(0)\n\ts_barrier":::"memory");
  #undef DMA_K
  #undef DMA_V
  #undef CMASK
  #undef START
  #undef RESC
  #undef ROT
}
constexpr int ATTN_LDS_BYTES=LDS_BYTES;
#undef SBAR
#undef WAIT_BAR
}
#define LAS __attribute__((address_space(3)))
typedef unsigned short u16;
typedef unsigned U4 __attribute__((ext_vector_type(4)));
typedef unsigned U2 __attribute__((ext_vector_type(2)));
typedef float F4 __attribute__((ext_vector_type(4)));
typedef float F2 __attribute__((ext_vector_type(2)));
typedef short S8 __attribute__((ext_vector_type(8)));
typedef float F16v __attribute__((ext_vector_type(16)));

constexpr int NWAVES = 8, NTHR = 512;
constexpr int L = 16384, CTX = 256, M = L + CTX, D = 1024, FH = 2816;
constexpr float EPS = 1e-6f;
constexpr int LDS_BYTES = 147456;
constexpr size_t MiB = 1u << 20;
constexpr size_t WS_MOD = 64 * 1024, WS_STATS = 512 * 1024;
constexpr size_t SZ_FI = (size_t)5632 * 1024 * 2, SZ_FO = (size_t)1024 * 2816 * 2;
constexpr size_t W_L0 = 1 * MiB, W_FI0 = W_L0, W_FO0 = W_FI0 + SZ_FI, W_GMI = W_FO0 + SZ_FO, W_GMO = W_GMI + (size_t)4096 * 1024 * 2;
constexpr size_t W_L1 = W_GMO + (size_t)1024 * 2048 * 2, W_FI1 = W_L1, W_FO1 = W_FI1 + SZ_FI, W_QKV = W_FO1 + SZ_FO, W_ATO = W_QKV + (size_t)1536 * 1024 * 2;
constexpr size_t W_L2 = W_ATO + (size_t)1024 * 1024 * 2, W_FI2 = W_L2, W_FO2 = W_FI2 + SZ_FI, W_HYI = W_FO2 + SZ_FO, W_HYO = W_HYI + (size_t)3072 * 1024 * 2;
constexpr size_t W_L3 = W_HYO + (size_t)1024 * 1024 * 2, W_FI3 = W_L3, W_FO3 = W_FI3 + SZ_FI, W_SSI = W_FO3 + SZ_FO, W_SSO = W_SSI + (size_t)5376 * 1024 * 2;
constexpr size_t W_END = W_SSO + (size_t)1024 * 2048 * 2;
constexpr size_t WS_YF = 1 * MiB;
static_assert(WS_YF + 64 * MiB <= W_L3, "y_fwd overlay must not touch layer 3 weights");
constexpr size_t WS_X = 107 * MiB; static_assert(W_END <= WS_X, "weights");
constexpr size_t WS_H = 172 * MiB, WS_CB = WS_H, WS_BT = WS_H + (size_t)130 * 4 * 128 * 128 * 2;
constexpr size_t WS_BIG = 205 * MiB;
constexpr size_t B_U = WS_BIG, B_V = WS_BIG + 65 * MiB;
constexpr size_t B_ACT = WS_BIG;
constexpr size_t B_QKVR = WS_BIG, B_Q = WS_BIG + 49 * MiB, B_K = WS_BIG + 82 * MiB, B_VV = WS_BIG + 91 * MiB;
constexpr size_t B_P = WS_BIG, B_KK = WS_BIG, B_YT = WS_BIG + 64 * MiB, B_X0 = WS_BIG + 98 * MiB, B_UT = WS_BIG + 131 * MiB;
constexpr size_t B_Z = WS_BIG, B_XBC = WS_BIG + 65 * MiB, B_DT = WS_BIG + 163 * MiB;
constexpr size_t WS_ACS2 = 65 * MiB, WS_DTV = 70 * MiB;
static_assert(WS_DTV + (size_t)64 * M * 4 <= W_L3 && WS_YF + 64 * MiB <= WS_ACS2, "scan decay tables");
constexpr size_t WS_WV = WS_BIG + 168 * MiB, WS_TOT = WS_WV + 5 * MiB;
constexpr size_t WS_STATSP = WS_BIG + 131 * MiB;
constexpr size_t WS_PART = WS_BIG + 131 * MiB;
constexpr size_t WS_END = WS_BIG + 179 * MiB;
constexpr size_t OUT_KK = 0, OUT_HALO = 8 * MiB;
constexpr size_t WS_HID2 = WS_BIG + 174 * MiB;

typedef float f32x2_t __attribute__((ext_vector_type(2))); typedef __bf16 bf16x2_t __attribute__((ext_vector_type(2)));
__device__ __forceinline__ unsigned pk2(float lo, float hi) { const f32x2_t v = {lo, hi}; const bf16x2_t b = __builtin_convertvector(v, bf16x2_t); return __builtin_bit_cast(unsigned, b); }
__device__ __forceinline__ unsigned f2bf(float f) { return pk2(f, f) & 0xffffu; }
__device__ __forceinline__ float bflo(unsigned w) { return __uint_as_float(w << 16); }
__device__ __forceinline__ float bfhi(unsigned w) { return __uint_as_float(w & 0xffff0000u); }
__device__ __forceinline__ float bf1(u16 h) { return __uint_as_float((unsigned)h << 16); }
__device__ __forceinline__ float wave_sum(float v) {
#pragma unroll
    for (int o = 1; o < 64; o <<= 1) v += __shfl_xor(v, o);
    return v;
}
__device__ __forceinline__ void unpack8(const U4 w, float (&f)[8]) { f[0] = bflo(w.x); f[1] = bfhi(w.x); f[2] = bflo(w.y); f[3] = bfhi(w.y); f[4] = bflo(w.z); f[5] = bfhi(w.z); f[6] = bflo(w.w); f[7] = bfhi(w.w); }
__device__ __forceinline__ U4 pack8(const float (&f)[8]) { U4 w; w.x = pk2(f[0], f[1]); w.y = pk2(f[2], f[3]); w.z = pk2(f[4], f[5]); w.w = pk2(f[6], f[7]); return w; }
__device__ __forceinline__ float softplus_f(float x) { return x > 15.f ? x : log1pf(__expf(x)); }

#define LDS_BAR() asm volatile("s_waitcnt lgkmcnt(0)\n\ts_barrier" ::: "memory")
struct Args { const float* in[40]; float* out; unsigned char* ws; int ph_lo, ph_hi; };
enum { I_X = 0, I_C, I_CTX, I_CCTX, I_N1G, I_N2G, I_MODW, I_MODB, I_FFI, I_FFO, I_FING, I_GMWI, I_GMLG, I_GMLB, I_GMWS, I_GMBS, I_GMWO, I_ATQKV, I_ATQG, I_ATKG, I_ATWO,
       I_HYWI, I_HYCW, I_HYCB, I_HYW1, I_HYB1, I_HYW2, I_HYB2, I_HYW3, I_HYFR, I_HYSK, I_HYWO, I_SSWI, I_SSCW, I_SSCB, I_SSAL, I_SSDB, I_SSDS, I_SSNG, I_SSWO };

__device__ __forceinline__ void p0_transpose_item(const float* W, int K, int N, u16* WT, int mode, float* scr, int item, int lane) {
    const int nblk = N / 32, kb = item / nblk, nb = item % nblk, k0 = 64 * kb, n0 = 32 * nb;
#pragma unroll 8
    for (int i = 0; i < 32; ++i) { const int kk = 2 * i + (lane >> 5); scr[kk * 33 + (lane & 31)] = W[(size_t)(k0 + kk) * N + n0 + (lane & 31)]; }
    __builtin_amdgcn_wave_barrier(); asm volatile("s_waitcnt lgkmcnt(0)" ::: "memory");
    int rbase = n0;
    if (mode == 1) { if (n0 < 2816) rbase = 256 * (n0 >> 7) + (n0 & 127); else { const int n1 = n0 - 2816; rbase = 256 * (n1 >> 7) + 128 + (n1 & 127); } }
    const int c = lane & 7;
#pragma unroll
    for (int j = 0; j < 4; ++j) { const int n = (lane >> 3) + 8 * j; const float* s = scr + (8 * c) * 33 + n;
        U4 o; o.x = pk2(s[0 * 33], s[1 * 33]); o.y = pk2(s[2 * 33], s[3 * 33]); o.z = pk2(s[4 * 33], s[5 * 33]); o.w = pk2(s[6 * 33], s[7 * 33]);
        *(U4*)(WT + (size_t)(rbase + n) * K + k0 + 8 * c) = o; }
    asm volatile("s_waitcnt lgkmcnt(0)" ::: "memory"); __builtin_amdgcn_wave_barrier();
}

__device__ __forceinline__ void convert_layer(const Args& a, int ly, unsigned char* lds, int vb, int nb) {
    const int tid = TIDX(), lane = tid & 63, wave = __builtin_amdgcn_readfirstlane(tid >> 6);
    unsigned char* ws = a.ws;
    float* scr = (float*)(lds + wave * 16384);
    const int gw = vb * NWAVES + wave, NGW = nb * NWAVES;
    constexpr int T_FI = 16 * 176, T_FO = 44 * 32, T_GMI = 16 * 128, T_GMO = 32 * 32, T_QKV = 16 * 48, T_ATO = 16 * 32, T_HYI = 16 * 96, T_HYO = 16 * 32, T_SSI = 16 * 162, T_SSO = 32 * 32;
    const int t_in = ly == 0 ? T_GMI : ly == 1 ? T_QKV : ly == 2 ? T_HYI : T_SSI, t_out = ly == 0 ? T_GMO : ly == 1 ? T_ATO : ly == 2 ? T_HYO : T_SSO;
    const size_t o_fi = ly == 0 ? W_FI0 : ly == 1 ? W_FI1 : ly == 2 ? W_FI2 : W_FI3, o_fo = ly == 0 ? W_FO0 : ly == 1 ? W_FO1 : ly == 2 ? W_FO2 : W_FO3;
    const int nit = T_FI + T_FO + t_in + t_out;
    for (int it = gw; it < nit; it += NGW) {
        int r = it;
        if (r < T_FI) { p0_transpose_item(a.in[I_FFI] + (size_t)ly * 1024 * 5632, 1024, 5632, (u16*)(ws + o_fi), 1, scr, r, lane); continue; } r -= T_FI;
        if (r < T_FO) { p0_transpose_item(a.in[I_FFO] + (size_t)ly * 2816 * 1024, 2816, 1024, (u16*)(ws + o_fo), 0, scr, r, lane); continue; } r -= T_FO;
        if (r < t_in) {
            if (ly == 0) p0_transpose_item(a.in[I_GMWI], 1024, 4096, (u16*)(ws + W_GMI), 0, scr, r, lane);
            else if (ly == 1) p0_transpose_item(a.in[I_ATQKV], 1024, 1536, (u16*)(ws + W_QKV), 0, scr, r, lane);
            else if (ly == 2) p0_transpose_item(a.in[I_HYWI], 1024, 3072, (u16*)(ws + W_HYI), 0, scr, r, lane);
            else p0_transpose_item(a.in[I_SSWI], 1024, 5184, (u16*)(ws + W_SSI), 0, scr, r, lane);
            continue; } r -= t_in;
        if (ly == 0) p0_transpose_item(a.in[I_GMWO], 2048, 1024, (u16*)(ws + W_GMO), 0, scr, r, lane);
        else if (ly == 1) p0_transpose_item(a.in[I_ATWO], 1024, 1024, (u16*)(ws + W_ATO), 0, scr, r, lane);
        else if (ly == 2) p0_transpose_item(a.in[I_HYWO], 1024, 1024, (u16*)(ws + W_HYO), 0, scr, r, lane);
        else p0_transpose_item(a.in[I_SSWO], 2048, 1024, (u16*)(ws + W_SSO), 0, scr, r, lane);
    }
    if (ly == 3) {
        U4* z = (U4*)(ws + W_SSI + (size_t)5184 * 1024 * 2); const U4 zero = {0u, 0u, 0u, 0u};
        for (int i = vb * NTHR + tid; i < 192 * 1024 / 8; i += nb * NTHR) z[i] = zero; }
}

__device__ __forceinline__ void phase_prologue(const Args& a, unsigned char* lds, int bid, int G) {
    const int tid = TIDX(), lane = tid & 63, wave = __builtin_amdgcn_readfirstlane(tid >> 6);
    unsigned char* ws = a.ws;
    float* scr = (float*)(lds + wave * 16384);
    const int gw = bid * NWAVES + wave, NGW = G * NWAVES;
    convert_layer(a, 0, lds, bid, G);
    {
        float* HID2 = (float*)(ws + WS_HID2);
        const float* w1 = a.in[I_HYW1]; const float* w2 = a.in[I_HYW2];
        const float b1 = a.in[I_HYB1][lane], b2 = a.in[I_HYB2][lane], fr = a.in[I_HYFR][lane];
        for (int pos = gw; pos < M; pos += NGW) {
            const int idx = pos < CTX ? pos : pos - CTX; const float Lc = pos < CTX ? 256.f : 16384.f;
            float feat = 0.f;
            if (lane == 0) feat = (float)idx / (Lc - 1.f);
            else if (lane <= 32) { const int b = (lane - 1) & 15; const float f = 1e-4f + (float)b * ((15.f - 1e-4f) / 15.f); const float rev = ((float)idx / Lc) * f;
                feat = lane <= 16 ? __builtin_amdgcn_cosf(rev) : -__builtin_amdgcn_sinf(rev); }
            float acc = b1;
#pragma unroll 11
            for (int e = 0; e < 33; ++e) acc += __shfl(feat, e) * w1[e * 64 + lane];
            const float h1 = __sinf(fr * acc);
            float acc2 = b2;
#pragma unroll 16
            for (int e = 0; e < 64; ++e) acc2 += __shfl(h1, e) * w2[e * 64 + lane];
            HID2[(size_t)pos * 64 + lane] = __sinf(fr * acc2);
        }
    }
    {
        float* MOD = (float*)(ws + WS_MOD); float* red = (float*)lds;
        __syncthreads();
        for (int it = bid; it < 4 * 192; it += G) {
            const int ly = it / 192, cg = it % 192, n = cg * 32 + (lane & 31), kpar = lane >> 5;
            const float* Wm = a.in[I_MODW] + (size_t)ly * 1024 * 6144;
            float a0 = 0.f, a1 = 0.f;
#pragma unroll 8
            for (int k = wave * 128 + kpar; k < wave * 128 + 128; k += 2) { const float w = Wm[(size_t)k * 6144 + n]; a0 += silu_f(a.in[I_C][k]) * w; a1 += silu_f(a.in[I_CCTX][k]) * w; }
            a0 += __shfl_xor(a0, 32); a1 += __shfl_xor(a1, 32);
            if (lane < 32) { red[(wave * 2 + 0) * 32 + lane] = a0; red[(wave * 2 + 1) * 32 + lane] = a1; }
            __syncthreads();
            if (tid < 64) { const int which = tid >> 5, nn = cg * 32 + (tid & 31); float s = a.in[I_MODB][ly * 6144 + nn];
#pragma unroll
                for (int w = 0; w < 8; ++w) s += red[(w * 2 + which) * 32 + (tid & 31)];
                MOD[((size_t)ly * 2 + which) * 6144 + nn] = s; }
            __syncthreads();
        }
    }
}
__device__ __forceinline__ void phase_norm_mod(float* src_ctx, const float* src_lat, float* Xcopy, const float* gain, const float* modL, const float* modC, int sh_off, int sc_off,
                                               u16* H, int row_lo, const float* part, int nks, const float* pgate, int bid, int G) {
    const int lane = TIDX() & 63, wave = __builtin_amdgcn_readfirstlane(TIDX() >> 6);
    const int gw = bid * NWAVES + wave, NGW = G * NWAVES;
#pragma unroll 1
    for (int pass = (row_lo >= CTX ? 1 : 0); pass < 2; ++pass) {
        const float* mod = pass == 0 ? modC : modL;
        F4 ga[4], sh[4];
#pragma unroll
        for (int j = 0; j < 4; ++j) { ga[j] = ((const F4*)gain)[lane + 64 * j] * (((const F4*)(mod + sc_off))[lane + 64 * j] + 1.0f); sh[j] = ((const F4*)(mod + sh_off))[lane + 64 * j]; }
        const int rbeg = pass == 0 ? row_lo : (row_lo > CTX ? row_lo : CTX), rend = pass == 0 ? CTX : M;
        F4 vn[4];
        { const int r0 = rbeg + gw; if (r0 < rend) { const F4* xr = (const F4*)(r0 < CTX ? src_ctx + (size_t)r0 * D : src_lat + (size_t)(r0 - CTX) * D) + lane;
#pragma unroll
            for (int j = 0; j < 4; ++j) vn[j] = xr[64 * j]; } }
        for (int r = rbeg + gw; r < rend; r += NGW) {
            F4 v[4]; float s = 0.f;
#pragma unroll
            for (int j = 0; j < 4; ++j) v[j] = vn[j];
            { const int rn = r + NGW; if (rn < rend) { const F4* xr = (const F4*)(rn < CTX ? src_ctx + (size_t)rn * D : src_lat + (size_t)(rn - CTX) * D) + lane;
#pragma unroll
                for (int j = 0; j < 4; ++j) vn[j] = xr[64 * j]; } }
            if (part && r < CTX) {
#pragma unroll
                for (int j = 0; j < 4; ++j) { F4 ps = {0.f, 0.f, 0.f, 0.f}; for (int kz = 0; kz < nks; ++kz) ps += ((const F4*)(part + ((size_t)kz * 256 + r) * D))[lane + 64 * j];
                    v[j] += ((const F4*)pgate)[lane + 64 * j] * ps; ((F4*)(src_ctx + (size_t)r * D))[lane + 64 * j] = v[j]; }
            }
#pragma unroll
            for (int j = 0; j < 4; ++j) s += (v[j].x * v[j].x + v[j].y * v[j].y) + (v[j].z * v[j].z + v[j].w * v[j].w);
            const float rstd = rsqrtf(wave_sum(s) * (1.f / D) + EPS);
            if (Xcopy) { F4* xc = (F4*)(Xcopy + (size_t)r * D) + lane;
#pragma unroll
                for (int j = 0; j < 4; ++j) xc[64 * j] = v[j]; }
            U2* o8 = (U2*)(H + (size_t)r * D) + lane;
#pragma unroll
            for (int j = 0; j < 4; ++j) { const F4 y = v[j] * rstd * ga[j] + sh[j]; U2 w; w.x = pk2(y.x, y.y); w.y = pk2(y.z, y.w); o8[64 * j] = w; }
        }
    }
}
__device__ __forceinline__ void phase_ln_stats(const u16* V, float* STATS, int bid, int G) {
    const int lane = TIDX() & 63, wave = __builtin_amdgcn_readfirstlane(TIDX() >> 6);
    const int gw = bid * NWAVES + wave, NGW = G * NWAVES;
    for (int r = gw; r < M; r += NGW) {
        const U4* vr = (const U4*)(V + (size_t)r * 2048) + lane;
        float f[4][8]; float s = 0.f;
#pragma unroll
        for (int j = 0; j < 4; ++j) { unpack8(vr[64 * j], f[j]);
#pragma unroll
            for (int e = 0; e < 8; ++e) s += f[j][e]; }
        const float mean = wave_sum(s) * (1.f / 2048.f); float q = 0.f;
#pragma unroll
        for (int j = 0; j < 4; ++j)
#pragma unroll
            for (int e = 0; e < 8; ++e) { const float d = f[j][e] - mean; q += d * d; }
        const float rstd = rsqrtf(wave_sum(q) * (1.f / 2048.f) + EPS);
        if (lane == 0) { STATS[2 * r] = mean; STATS[2 * r + 1] = rstd; }
    }
}
__device__ __forceinline__ void phase_qk_rope(const u16* QKVR, const float* q_g, const float* k_g, u16* Qb, u16* Kb, u16* Vb, int bid, int G) {
    const int lane = TIDX() & 63, wave = __builtin_amdgcn_readfirstlane(TIDX() >> 6), l16 = lane & 15, hq = lane >> 4;
    const int gw = bid * NWAVES + wave, NGW = G * NWAVES;
    const int e0 = 4 * l16, i0 = e0 & 31;
    const F4 qg = *(const F4*)(q_g + e0), kg = *(const F4*)(k_g + e0);
    float inv[4];
#pragma unroll
    for (int j = 0; j < 4; ++j) inv[j] = exp2f(-(float)((i0 + j) & 15) * (13.287712379549449f / 16.f));
    constexpr float C2 = 0.125f * 1.4426950408889634f;
    for (int r = gw; r < M; r += NGW) {
        float cs[4] = {1.f, 1.f, 1.f, 1.f}, sn[4] = {0.f, 0.f, 0.f, 0.f};
        if (r >= CTX) { const int t = r - CTX; const float pos = i0 < 16 ? (float)(t >> 6) : (float)(t & 63);
#pragma unroll
            for (int j = 0; j < 4; ++j) { const float a = pos * inv[j]; cs[j] = __cosf(a); sn[j] = __sinf(a); } }
        const U2* row = (const U2*)(QKVR + (size_t)r * 1536);
#pragma unroll
        for (int i = 0; i < 6; ++i) {
            const U2 w = row[64 * i + lane]; const int hd = 4 * i + hq;
            if (i == 5) { ((U2*)(Vb + (size_t)r * 256))[(hd - 20) * 16 + l16] = w; continue; }
            float v[4] = {bflo(w.x), bfhi(w.x), bflo(w.y), bfhi(w.y)};
            float ss = (v[0] * v[0] + v[1] * v[1]) + (v[2] * v[2] + v[3] * v[3]);
#pragma unroll
            for (int o = 1; o < 16; o <<= 1) ss += __shfl_xor(ss, o);
            const float rs = rsqrtf(ss * (1.f / 64.f) + EPS);
            const bool isq = i < 4; const F4 gn = isq ? qg : kg;
            float y[4], p[4];
#pragma unroll
            for (int j = 0; j < 4; ++j) y[j] = v[j] * rs * gn[j];
#pragma unroll
            for (int j = 0; j < 4; ++j) p[j] = __shfl_xor(y[j], 8);
#pragma unroll
            for (int j = 0; j < 4; ++j) y[j] = l16 < 8 ? y[j] * cs[j] - p[j] * sn[j] : y[j] * cs[j] + p[j] * sn[j];
            U2 o2;
            if (isq) { o2.x = pk2(y[0] * C2, y[1] * C2); o2.y = pk2(y[2] * C2, y[3] * C2); ((U2*)(Qb + (size_t)r * 1024))[hd * 16 + l16] = o2; }
            else { o2.x = pk2(y[0], y[1]); o2.y = pk2(y[2], y[3]); ((U2*)(Kb + (size_t)r * 256))[(hd - 16) * 16 + l16] = o2; }
        }
    }
}
__device__ __forceinline__ void phase_ssd_finish(const u16* YF, const u16* YB, const u16* XBC, u16* Z, const float* d_skip, const float* norm_g, int bid, int G) {
    const int lane = TIDX() & 63, wave = __builtin_amdgcn_readfirstlane(TIDX() >> 6);
    const int gw = bid * NWAVES + wave, NGW = G * NWAVES;
    for (int t = gw; t < L; t += NGW) {
        const size_t R = (size_t)t + CTX;
        U4 wyf[4], wyb[4], wxs[4], wz[4];
#pragma unroll
        for (int j = 0; j < 4; ++j) { const int ch = 512 * j + 8 * lane;
            wyf[j] = *(const U4*)(YF + (size_t)t * 2048 + ch); wyb[j] = *(const U4*)(YB + (size_t)t * 2048 + ch);
            wxs[j] = *(const U4*)(XBC + R * 3072 + ch); wz[j] = *(const U4*)(Z + R * 2048 + ch); }
        U4 wo[4];
#pragma unroll
        for (int j = 0; j < 4; ++j) {
            const int ch = 512 * j + 8 * lane;
            float yf[8], yb[8], xs[8], z[8], o[8];
            unpack8(wyf[j], yf); unpack8(wyb[j], yb); unpack8(wxs[j], xs); unpack8(wz[j], z);
            const float ds = d_skip[ch >> 6]; float ss = 0.f;
#pragma unroll
            for (int e = 0; e < 8; ++e) { const float y = yf[e] + yb[e] + xs[e] * ds; o[e] = y * silu_f(z[e]); ss += o[e] * o[e]; }
            const float rs = rsqrtf(wave_sum(ss) * (1.f / 512.f) + EPS);
            const F4 g0 = *(const F4*)(norm_g + ch), g1 = *(const F4*)(norm_g + ch + 4);
            o[0] *= rs * g0.x; o[1] *= rs * g0.y; o[2] *= rs * g0.z; o[3] *= rs * g0.w; o[4] *= rs * g1.x; o[5] *= rs * g1.y; o[6] *= rs * g1.z; o[7] *= rs * g1.w;
            wo[j] = pack8(o);
        }
#pragma unroll
        for (int j = 0; j < 4; ++j) *(U4*)(Z + R * 2048 + 512 * j + 8 * lane) = wo[j];
    }
}
__device__ __forceinline__ void phase_final(const float* X, const float* gain, float* out, int bid, int G) {
    const int lane = TIDX() & 63, wave = __builtin_amdgcn_readfirstlane(TIDX() >> 6);
    const int gw = bid * NWAVES + wave, NGW = G * NWAVES;
    F4 gn[4];
#pragma unroll
    for (int j = 0; j < 4; ++j) gn[j] = ((const F4*)gain)[lane + 64 * j];
    F4 vn[4];
    if (gw < L) { const F4* xr = (const F4*)(X + (size_t)(gw + CTX) * D) + lane;
#pragma unroll
        for (int j = 0; j < 4; ++j) vn[j] = xr[64 * j]; }
    for (int t = gw; t < L; t += NGW) {
        F4 v[4]; float s = 0.f;
#pragma unroll
        for (int j = 0; j < 4; ++j) { v[j] = vn[j]; s += (v[j].x * v[j].x + v[j].y * v[j].y) + (v[j].z * v[j].z + v[j].w * v[j].w); }
        if (t + NGW < L) { const F4* xr = (const F4*)(X + (size_t)(t + NGW + CTX) * D) + lane;
#pragma unroll
            for (int j = 0; j < 4; ++j) vn[j] = xr[64 * j]; }
        const float rstd = rsqrtf(wave_sum(s) * (1.f / D) + EPS);
        F4* o = (F4*)(out + (size_t)t * D) + lane;
#pragma unroll
        for (int j = 0; j < 4; ++j) o[64 * j] = v[j] * rstd * gn[j];
    }
}
__device__ __forceinline__ void phase_spatial(u16* U, const u16* V, const float* STATS, const float* gws, const float* gbs, const float* lng, const float* lnb, unsigned char* lds, int bid, int G) {
    const int tid = TIDX(), lane = tid & 63, wave = __builtin_amdgcn_readfirstlane(tid >> 6), il = lane & 15, quad = lane >> 4;
    u16* wsL = (u16*)lds;
    u16* vnT = (u16*)(lds + 128 * 136 * 2);
    float* rst = (float*)(lds + 128 * 136 * 2 + 256 * 136 * 2);
    for (int it = bid; it < 130 * 8; it += G) {
        const int n = it >> 3, g = it & 7;
        __syncthreads();
        if (tid < 128) { const F4* sp = (const F4*)(STATS + ((size_t)n * 128 + tid) * 64); float s1 = 0.f, s2 = 0.f;
#pragma unroll
            for (int i = 0; i < 16; ++i) { const F4 v = sp[i]; s1 += v.x + v.z; s2 += v.y + v.w; }
            const float mean = s1 * (1.f / 2048.f); rst[2 * tid] = mean; rst[2 * tid + 1] = rsqrtf(fmaxf(s2 * (1.f / 2048.f) - mean * mean, 0.f) + EPS); }
        __syncthreads();
#pragma unroll
        for (int i = 0; i < 8; ++i) { const int piece = tid + NTHR * i, p = piece >> 5, q4 = (piece & 31) * 4;
            const F4 w = *(const F4*)(gws + ((size_t)g * 128 + p) * 128 + q4); U2 o; o.x = pk2(w.x, w.y); o.y = pk2(w.z, w.w); *(U2*)(wsL + p * 136 + q4) = o; }
#pragma unroll
        for (int i = 0; i < 4; ++i) { const int cc = wave + 8 * i, l2 = lane;
            const size_t row = (size_t)n * 128 + 2 * l2; const int c0 = g * 256 + cc * 8;
            float f0[8], f1[8]; unpack8(*(const U4*)(V + row * 2048 + c0), f0); unpack8(*(const U4*)(V + (row + 1) * 2048 + c0), f1);
            const float m0 = rst[4 * l2], r0 = rst[4 * l2 + 1], m1 = rst[4 * l2 + 2], r1 = rst[4 * l2 + 3];
            const F4 ga = *(const F4*)(lng + c0), gb = *(const F4*)(lng + c0 + 4), ba = *(const F4*)(lnb + c0), bb = *(const F4*)(lnb + c0 + 4);
            const float gg[8] = {ga.x, ga.y, ga.z, ga.w, gb.x, gb.y, gb.z, gb.w}, bbv[8] = {ba.x, ba.y, ba.z, ba.w, bb.x, bb.y, bb.z, bb.w};
            unsigned* vt = (unsigned*)vnT + (cc * 8) * 68 + l2;
#pragma unroll
            for (int e = 0; e < 8; ++e) vt[e * 68] = pk2((f0[e] - m0) * r0 * gg[e] + bbv[e], (f1[e] - m1) * r1 * gg[e] + bbv[e]); }
        __syncthreads();
        F4 acc[8][2];
#pragma unroll
        for (int mt = 0; mt < 8; ++mt) { acc[mt][0] = (F4){0.f, 0.f, 0.f, 0.f}; acc[mt][1] = (F4){0.f, 0.f, 0.f, 0.f}; }
#pragma unroll
        for (int ks = 0; ks < 4; ++ks) {
            S8 vf[2], wf[8];
#pragma unroll
            for (int nt = 0; nt < 2; ++nt) vf[nt] = *(const S8*)(vnT + (32 * wave + 16 * nt + il) * 136 + 32 * ks + 8 * quad);
#pragma unroll
            for (int mt = 0; mt < 8; ++mt) wf[mt] = *(const S8*)(wsL + (16 * mt + il) * 136 + 32 * ks + 8 * quad);
#pragma unroll
            for (int mt = 0; mt < 8; ++mt)
#pragma unroll
                for (int nt = 0; nt < 2; ++nt) acc[mt][nt] = __builtin_amdgcn_mfma_f32_16x16x32_bf16(vf[nt], wf[mt], acc[mt][nt], 0, 0, 0);
        }
#pragma unroll
        for (int mt = 0; mt < 8; ++mt) { const int p = 16 * mt + il; const float b = gbs[g * 128 + p];
#pragma unroll
            for (int nt = 0; nt < 2; ++nt) { U2* up = (U2*)(U + ((size_t)n * 128 + p) * 2048 + g * 256 + 32 * wave + 16 * nt + 4 * quad); const U2 uu = *up;
                U2 o; o.x = pk2(bflo(uu.x) * (acc[mt][nt][0] + b), bfhi(uu.x) * (acc[mt][nt][1] + b)); o.y = pk2(bflo(uu.y) * (acc[mt][nt][2] + b), bfhi(uu.y) * (acc[mt][nt][3] + b)); *up = o; } }
    }
}
__device__ __forceinline__ void phase_attention(const u16* Qb, const u16* Kb, const u16* Vb, u16* Ob, unsigned char* lds, int bid, int G) {
    using namespace attn_body;
    for (int u = bid; u < 1024 + 16; u += G) {
        int qrow0, h, NT;
        if (u < 1024) { h = u >> 6; qrow0 = CTX + (u & 63) * 256; NT = M / 64; } else { h = u - 1024; qrow0 = 0; NT = CTX / 64; }
        attn_unit<8>(qrow0, h, NT, (const bf16*)Qb, (const bf16*)Kb, (const bf16*)Vb, (bf16*)Ob, (char*)lds);
    }
}
__device__ __forceinline__ void phase_hy_dwconv(const u16* P, const float* cw, const float* cb, u16* X0, u16* UT, unsigned char* lds, int bid, int G) {
    const int tid = TIDX(); u16* uL = (u16*)lds;
    const int cc = tid & 7, rg = tid >> 3;
    for (int it = bid; it < 65 * 16; it += G) {
        const int rt = it >> 4, ct = it & 15;
        __syncthreads();
        float uo[4][8];
#pragma unroll
        for (int grp = 0; grp < 3; ++grp) {
            const int col = grp * 1024 + ct * 64 + cc * 8;
            float w0[8], w1[8], w2[8], bb[8];
#pragma unroll
            for (int h2 = 0; h2 < 2; ++h2) { const F4 a = *(const F4*)(cw + col + 4 * h2), b = *(const F4*)(cw + 3072 + col + 4 * h2), c = *(const F4*)(cw + 6144 + col + 4 * h2), d = *(const F4*)(cb + col + 4 * h2);
#pragma unroll
                for (int e = 0; e < 4; ++e) { w0[4 * h2 + e] = a[e]; w1[4 * h2 + e] = b[e]; w2[4 * h2 + e] = c[e]; bb[4 * h2 + e] = d[e]; } }
            const int Rb = rt * 256 + rg * 4;
            const U4 zero = {0u, 0u, 0u, 0u};
            float pv[8], cv[8], nv[8];
            unpack8((Rb != 0 && Rb != CTX) ? *(const U4*)(P + (size_t)(Rb - 1) * 3072 + col) : zero, pv);
            unpack8(*(const U4*)(P + (size_t)Rb * 3072 + col), cv);
#pragma unroll
            for (int r = 0; r < 4; ++r) {
                const int R = Rb + r;
                unpack8((R != CTX - 1 && R != M - 1) ? *(const U4*)(P + (size_t)(R + 1) * 3072 + col) : zero, nv);
                float val[8];
#pragma unroll
                for (int e = 0; e < 8; ++e) { val[e] = pv[e] * w0[e] + cv[e] * w1[e] + nv[e] * w2[e] + bb[e]; pv[e] = cv[e]; cv[e] = nv[e]; }
                if (grp == 0) *(U4*)(X0 + (size_t)R * 1024 + ct * 64 + cc * 8) = pack8(val);
                else if (grp == 1) {
#pragma unroll
                    for (int e = 0; e < 8; ++e) uo[r][e] = val[e];
                } else {
#pragma unroll
                    for (int e = 0; e < 8; ++e) uo[r][e] *= val[e];
                }
            }
        }
#pragma unroll
        for (int e = 0; e < 8; ++e) { U2 o; o.x = pk2(uo[0][e], uo[1][e]); o.y = pk2(uo[2][e], uo[3][e]); *(U2*)(uL + (cc * 8 + e) * 264 + rg * 4) = o; }
        __syncthreads();
        { const int ch = tid >> 3, piece = tid & 7;
#pragma unroll
          for (int k2 = 0; k2 < 4; ++k2) { const int off = (piece + 8 * k2) * 8; *(U4*)(UT + (size_t)(ct * 64 + ch) * M + rt * 256 + off) = *(const U4*)(uL + ch * 264 + off); } }
    }
}
__device__ __forceinline__ float hy_delta(int d) { return 3.0701134573253946f + (float)d * ((15.350567286626973f - 3.0701134573253946f) / 1023.f); }
__device__ __forceinline__ void phase_hy_ktgen(const float* HID2, const float* w3, const float* skip, u16* KK, unsigned char* lds, int bid, int G) {
    const int tid = TIDX(), t = tid & 63, dg = __builtin_amdgcn_readfirstlane(tid >> 6);
    float* hs = (float*)lds; float* wf = hs + 64 * 65; float* wb = wf + 64 * 64;
    if (bid < 12) return;
    for (int it = bid - 12; it < 256 * 16; it += G - 12) {
        const int tt = it >> 4, dt = it & 15;
        __syncthreads();
#pragma unroll
        for (int i = 0; i < 8; ++i) { const int id = tid + NTHR * i, a = id >> 6, e = id & 63;
            hs[a * 65 + e] = HID2[(size_t)(CTX + 64 * tt + a) * 64 + e];
            wf[a * 64 + e] = w3[(size_t)a * 2048 + 64 * dt + e]; wb[a * 64 + e] = w3[(size_t)a * 2048 + 1024 + 64 * dt + e]; }
        __syncthreads();
        float af[8], ab[8];
#pragma unroll
        for (int q = 0; q < 8; ++q) { af[q] = 0.f; ab[q] = 0.f; }
#pragma unroll 4
        for (int e = 0; e < 64; ++e) { const float h = hs[t * 65 + e];
            const F4 f0 = *(const F4*)(wf + e * 64 + 8 * dg), f1 = *(const F4*)(wf + e * 64 + 8 * dg + 4), b0 = *(const F4*)(wb + e * 64 + 8 * dg), b1 = *(const F4*)(wb + e * 64 + 8 * dg + 4);
            af[0] += h * f0.x; af[1] += h * f0.y; af[2] += h * f0.z; af[3] += h * f0.w; af[4] += h * f1.x; af[5] += h * f1.y; af[6] += h * f1.z; af[7] += h * f1.w;
            ab[0] += h * b0.x; ab[1] += h * b0.y; ab[2] += h * b0.z; ab[3] += h * b0.w; ab[4] += h * b1.x; ab[5] += h * b1.y; ab[6] += h * b1.z; ab[7] += h * b1.w; }
        const int tpos = 64 * tt + t; const float tn = (float)tpos / 16383.f;
#pragma unroll
        for (int q = 0; q < 8; ++q) { const int d = 64 * dt + 8 * dg + q; const float dec = __expf(-tn * hy_delta(d));
            float vf = af[q] * dec; if (tpos == 0) vf += skip[d];
            KK[(size_t)d * 32768 + 16384 + tpos] = (u16)f2bf(vf);
            if (tpos == 0) KK[(size_t)d * 32768] = 0; else KK[(size_t)d * 32768 + 16384 - tpos] = (u16)f2bf(ab[q] * dec); }
    }
}
__device__ __forceinline__ int ur_phys(int g) { return (g & ~15) | ((g ^ (g >> 4)) & 15); }
__device__ __forceinline__ void conv_build_load(const unsigned* kk32, int k0, int wave, int lane, unsigned (&v)[18]) {
#pragma unroll
    for (int i = 0; i < 18; ++i) { const int idx = 8 * k0 + lane + 64 * i + (wave >> 1); v[i] = (idx < 16384 && i < 17) ? kk32[idx] : 0u; }
}
__device__ __forceinline__ void conv_build_store(unsigned* sh, int wave, int lane, const unsigned (&v)[18]) {
#pragma unroll
    for (int i = 0; i < 17; ++i) { const int w = lane + 64 * i; unsigned o = v[i];
        if (wave & 1) { unsigned nx = __shfl_down(v[i], 1); const unsigned n0 = __shfl(v[i + 1], 0); if (lane == 63) nx = n0; o = (v[i] >> 16) | (nx << 16); }
        if (w < 1064) sh[w] = o; }
}
__device__ __forceinline__ void phase_hy_conv(const u16* KK, const u16* UT, u16* YT, const float* HID2, const float* w3, const float* skip, unsigned char* lds, int bid, int G) {
    const int tid = TIDX(), lane = tid & 63, wave = __builtin_amdgcn_readfirstlane(tid >> 6), n32 = lane & 31, hi = lane >> 5;
    constexpr int UR_B = 0, UR_N = 20480, SH_B = UR_N * 2, SHB = 4416, SHBUF = 8 * SHB;
    u16* UR = (u16*)(lds + UR_B);
    for (int it = bid; it < 2048; it += G) {
        __syncthreads();
        if (it < 1024) {
            const int d = it;
            const unsigned* kk32 = (const unsigned*)(KK + (size_t)d * 32768);
            unsigned pv[18];
            conv_build_load(kk32, 0, wave, lane, pv);
            { U4* ur = (U4*)UR; const U4 zero = {0u, 0u, 0u, 0u}; for (int i = tid; i < UR_N / 8; i += NTHR) ur[i] = zero; }
            __syncthreads();
#pragma unroll
            for (int i = 0; i < 4; ++i) { const int s0 = (tid + NTHR * i) * 8; float f[8]; unpack8(*(const U4*)(UT + (size_t)d * M + CTX + s0), f);
#pragma unroll
                for (int e = 0; e < 8; ++e) { const int y = L + 2048 - (s0 + e); UR[(ur_phys(y >> 3) << 3) | (y & 7)] = (u16)f2bf(f[e]); } }
            conv_build_store((unsigned*)(lds + SH_B + wave * SHB), wave, lane, pv);
            __syncthreads();
            F16v acc0, acc1;
#pragma unroll
            for (int r = 0; r < 16; ++r) { acc0[r] = 0.f; acc1[r] = 0.f; }
            const int I = wave, ii = 32 * I + n32;
            const int gb = hi - 8 * ii + 256;
            const int aoff = SH_B + (n32 & 7) * SHB + ((n32 >> 3) * 8 + 8 * hi) * 2;
            for (int c = 0; c < 16; ++c) {
                const int k0 = 128 * c;
                if (c + 1 < 16) conv_build_load(kk32, k0 + 128, wave, lane, pv);
                if (c >= I && c <= I + 8) {
                    const unsigned char* ab = lds + aoff + (c & 1) * SHBUF;
#define CONV_A(kk) (*(const S8*)(ab + 32 * (kk)))
#define CONV_B(kk) (*(const S8*)(UR + (ur_phys(gb + 2 * (k0 + (kk))) << 3)))
#define CONV_MM(a_lo, a_hi, b) do { acc0 = __builtin_amdgcn_mfma_f32_32x32x16_bf16(a_lo, b, acc0, 0, 0, 0); acc1 = __builtin_amdgcn_mfma_f32_32x32x16_bf16(a_hi, b, acc1, 0, 0, 0); } while (0)
                    S8 ar[8], br[8];
#pragma unroll
                    for (int x = 0; x < 6; ++x) ar[x] = CONV_A(x);
#pragma unroll
                    for (int x = 0; x < 4; ++x) br[x] = CONV_B(x);
                    for (int k = 0; k < 128; k += 8) {
#pragma unroll
                        for (int j = 0; j < 8; ++j) {
                            ar[(6 + j) & 7] = CONV_A(k + 6 + j); br[(4 + j) & 7] = CONV_B(k + 4 + j);
                            __builtin_amdgcn_sched_barrier(0);
                            CONV_MM(ar[j & 7], ar[(j + 2) & 7], br[j & 7]);
                            __builtin_amdgcn_sched_barrier(0);
                        }
                    }
#undef CONV_A
#undef CONV_B
#undef CONV_MM
                }
                if (c + 1 < 16) conv_build_store((unsigned*)(lds + SH_B + ((c + 1) & 1) * SHBUF + wave * SHB), wave, lane, pv);
                __syncthreads();
            }
#pragma unroll
            for (int rg = 0; rg < 4; ++rg) { const int a0 = 8 * rg + 4 * hi;
                U2 o0; o0.x = pk2(acc0[4 * rg], acc0[4 * rg + 1]); o0.y = pk2(acc0[4 * rg + 2], acc0[4 * rg + 3]);
                U2 o1; o1.x = pk2(acc1[4 * rg], acc1[4 * rg + 1]); o1.y = pk2(acc1[4 * rg + 2], acc1[4 * rg + 3]);
                *(U2*)(YT + (size_t)d * M + CTX + 64 * ii + a0) = o0; *(U2*)(YT + (size_t)d * M + CTX + 64 * ii + 32 + a0) = o1; }
        } else {
            const int d = it - 1024; float* kkc = (float*)lds; float* uc = kkc + 512;
            if (tid < 511) { const int lag = tid - 255, m = lag < 0 ? -lag : lag; const float* hrow = HID2 + (size_t)m * 64; const float* wcol = w3 + (lag < 0 ? 1024 : 0) + d; float acc = 0.f;
#pragma unroll 8
                for (int e = 0; e < 64; ++e) acc += hrow[e] * wcol[(size_t)e * 2048];
                float v = acc * __expf(-((float)m / 255.f) * hy_delta(d)); if (lag == 0) v += skip[d]; kkc[tid] = v; }
            if (tid < 256) uc[tid] = bf1(UT[(size_t)d * M + tid]);
            __syncthreads();
            if (tid < 256) { float y = 0.f;
#pragma unroll 8
                for (int s = 0; s < 256; ++s) y += kkc[tid - s + 255] * uc[s];
                YT[(size_t)d * M + tid] = (u16)f2bf(y); }
        }
    }
}
__device__ __forceinline__ void phase_hy_tgate(u16* X0, const u16* YT, unsigned char* lds, int bid, int G) {
    const int tid = TIDX(); u16* yL = (u16*)lds;
    for (int it = bid; it < 65 * 16; it += G) {
        const int rt = it >> 4, ct = it & 15;
        __syncthreads();
        { const int ch = tid >> 3, piece = tid & 7;
#pragma unroll
          for (int k2 = 0; k2 < 4; ++k2) { const int off = (piece + 8 * k2) * 8; *(U4*)(yL + ch * 264 + off) = *(const U4*)(YT + (size_t)(ct * 64 + ch) * M + rt * 256 + off); } }
        __syncthreads();
        const int cc = tid & 7, rg = tid >> 3;
        float yv[4][8];
#pragma unroll
        for (int e = 0; e < 8; ++e) { const U2 w = *(const U2*)(yL + (cc * 8 + e) * 264 + rg * 4); yv[0][e] = bflo(w.x); yv[1][e] = bfhi(w.x); yv[2][e] = bflo(w.y); yv[3][e] = bfhi(w.y); }
#pragma unroll
        for (int r = 0; r < 4; ++r) { U4* xp = (U4*)(X0 + (size_t)(rt * 256 + rg * 4 + r) * 1024 + ct * 64 + cc * 8); float f[8]; unpack8(*xp, f);
#pragma unroll
            for (int e = 0; e < 8; ++e) f[e] *= yv[r][e];
            *xp = pack8(f); }
    }
}
__device__ __forceinline__ void phase_ssd_conv(u16* XBC, const u16* HALO, const float* cw, const float* cb, int bid, int G) {
    const int lane = TIDX() & 63, wave = __builtin_amdgcn_readfirstlane(TIDX() >> 6);
    const int gw = bid * NWAVES + wave, NGW = G * NWAVES;
    const U4 zero = {0u, 0u, 0u, 0u};
    for (int it = gw; it < (M / 32) * 6; it += NGW) {
        const int seg = it / 6, col = (it % 6) * 512 + 8 * lane;
        float w0[8], w1[8], w2[8], bb[8];
#pragma unroll
        for (int h2 = 0; h2 < 2; ++h2) { const F4 a = *(const F4*)(cw + col + 4 * h2), b = *(const F4*)(cw + 3072 + col + 4 * h2), c = *(const F4*)(cw + 6144 + col + 4 * h2), d = *(const F4*)(cb + col + 4 * h2);
#pragma unroll
            for (int e = 0; e < 4; ++e) { w0[4 * h2 + e] = a[e]; w1[4 * h2 + e] = b[e]; w2[4 * h2 + e] = c[e]; bb[4 * h2 + e] = d[e]; } }
        u16* base = XBC + (size_t)(seg * 32) * 3072 + col;
        U4 prevw = (seg == 0 || seg == CTX / 32) ? zero : *(const U4*)(HALO + ((size_t)(seg - 1) * 2 + 1) * 3072 + col);
        const U4 nextw = (seg == CTX / 32 - 1 || seg == M / 32 - 1) ? zero : *(const U4*)(HALO + ((size_t)(seg + 1) * 2) * 3072 + col);
#pragma unroll
        for (int half = 0; half < 2; ++half) {
            U4 rw[17];
#pragma unroll
            for (int r = 0; r < 17; ++r) { const int rr = 16 * half + r; rw[r] = rr < 32 ? *(const U4*)(base + (size_t)rr * 3072) : nextw; }
            float pv[8], cv[8], nv[8];
            unpack8(prevw, pv); unpack8(rw[0], cv);
#pragma unroll
            for (int r = 0; r < 16; ++r) {
                unpack8(rw[r + 1], nv);
                float o[8];
#pragma unroll
                for (int e = 0; e < 8; ++e) { o[e] = silu_f(pv[e] * w0[e] + cv[e] * w1[e] + nv[e] * w2[e] + bb[e]); pv[e] = cv[e]; cv[e] = nv[e]; }
                *(U4*)(base + (size_t)(16 * half + r) * 3072) = pack8(o);
            }
            prevw = rw[15];
        }
    }
}
__device__ __forceinline__ void phase_ssd_cb(const u16* XBC, u16* CB, u16* BT, const float* DT, const float* a_log, const float* dt_bias, float* ACS2, float* DTV, float* WV, float* TOT, unsigned char* lds, int bid, int G) {
    const int tid = TIDX(), lane = tid & 63, wave = __builtin_amdgcn_readfirstlane(tid >> 6), il = lane & 15, quad = lane >> 4;
    unsigned* T = (unsigned*)lds;
    for (int it = bid; it < 130 * 4; it += G) {
        const int c = it >> 2, g = it & 3;
        const int i = 16 * wave + il;
        __syncthreads();
#pragma unroll
        for (int q = 0; q < 2; ++q) { const int nc = 2 * wave + q;
            const U4 r0 = *(const U4*)(XBC + (size_t)(128 * c + 2 * lane) * 3072 + 2048 + 128 * g + 8 * nc), r1 = *(const U4*)(XBC + (size_t)(128 * c + 2 * lane + 1) * 3072 + 2048 + 128 * g + 8 * nc);
            const unsigned a[4] = {r0.x, r0.y, r0.z, r0.w}, b[4] = {r1.x, r1.y, r1.z, r1.w};
#pragma unroll
            for (int e2 = 0; e2 < 4; ++e2) { T[(8 * nc + 2 * e2) * 68 + lane] = (a[e2] & 0xffffu) | (b[e2] << 16); T[(8 * nc + 2 * e2 + 1) * 68 + lane] = (a[e2] >> 16) | (b[e2] & 0xffff0000u); } }
#pragma unroll
        for (int q2 = 0; q2 < 2; ++q2) { const int pr = 2 * wave + q2, dir = pr >> 3, h = 8 * g + (pr & 7), dh = dir * 32 + h;
            const float Ah = -__expf(a_log[dh]), dtb = dt_bias[dh];
            const size_t R0 = (size_t)c * 128;
            const float d0 = softplus_f(DT[(R0 + 2 * lane) * 64 + dh] + dtb), d1 = softplus_f(DT[(R0 + 2 * lane + 1) * 64 + dh] + dtb);
            const float a0 = d0 * Ah * 1.4426950408889634f, a1 = d1 * Ah * 1.4426950408889634f;
            float sc = a0 + a1, tot, c0, c1;
            if (dir == 0) {
#pragma unroll
                for (int o = 1; o < 64; o <<= 1) { const float t2 = __shfl_up(sc, o); if (lane >= o) sc += t2; }
                tot = __shfl(sc, 63); c0 = sc - a1; c1 = sc;
            } else {
#pragma unroll
                for (int o = 1; o < 64; o <<= 1) { const float t2 = __shfl_down(sc, o); if (lane + o < 64) sc += t2; }
                tot = __shfl(sc, 0); c0 = sc; c1 = sc - a0;
            }
            const size_t o2 = (size_t)dh * M + R0 + 2 * lane;
            *(F2*)(ACS2 + o2) = (F2){c0, c1}; *(F2*)(DTV + o2) = (F2){d0, d1};
            *(F2*)(WV + o2) = (F2){__builtin_amdgcn_exp2f(tot - c0) * d0, __builtin_amdgcn_exp2f(tot - c1) * d1};
            if (lane == 0) TOT[dh * 130 + c] = tot; }
        S8 cf[4];
#pragma unroll
        for (int ks = 0; ks < 4; ++ks) cf[ks] = *(const S8*)(XBC + (size_t)(128 * c + i) * 3072 + 2560 + 128 * g + 32 * ks + 8 * quad);
#pragma unroll
        for (int jt = 0; jt < 8; ++jt) {
            F4 acc = {0.f, 0.f, 0.f, 0.f};
#pragma unroll
            for (int ks = 0; ks < 4; ++ks) { const S8 bfr = *(const S8*)(XBC + (size_t)(128 * c + 16 * jt + il) * 3072 + 2048 + 128 * g + 32 * ks + 8 * quad);
                acc = __builtin_amdgcn_mfma_f32_16x16x32_bf16(bfr, cf[ks], acc, 0, 0, 0); }
            U2 o; o.x = pk2(acc[0], acc[1]); o.y = pk2(acc[2], acc[3]);
            *(U2*)(CB + (((size_t)c * 4 + g) * 128 + i) * 128 + 16 * jt + 4 * quad) = o;
        }
        __syncthreads();
        { const int n = tid >> 2, piece = tid & 3;
#pragma unroll
          for (int q = 0; q < 4; ++q) *(U4*)(BT + (((size_t)c * 4 + g) * 128 + n) * 128 + (piece * 4 + q) * 8) = *(const U4*)(T + n * 68 + (piece * 4 + q) * 4); }
    }
}
__device__ __forceinline__ int scan_chunk(int dir, int ci) { return dir == 0 ? ci : (ci < 2 ? 1 - ci : 131 - ci); }
__device__ __forceinline__ void phase_ssd_scan(const u16* XBC, const float* ACS2, const float* DTV, const float* WV, const float* TOT, const u16* CB, const u16* BT, u16* YF, u16* YB, u16* YDUMMY, unsigned char* lds, int bid, int G) {
    const int tid = TIDX(), lane = tid & 63, wave = __builtin_amdgcn_readfirstlane(tid >> 6), il = lane & 15, quad = lane >> 4;
    float* fb = (float*)lds;
    u16* XTb = (u16*)(lds + 4096);
    u16* HBFb = (u16*)(lds + 4096 + 4 * 4352);
    for (int it = bid; it < 256; it += G) {
        const int dir = it >> 7, h = (it & 127) >> 2, pq = it & 3, g = h >> 3;
        const size_t dhM = (size_t)(dir * 32 + h) * M; const float* totp = TOT + (dir * 32 + h) * 130;
        u16* Y = dir ? YB : YF;
        __syncthreads();
        for (int i = tid; i < 16 * 136; i += NTHR) HBFb[i] = 0;
        F4 hst = {0.f, 0.f, 0.f, 0.f};
        float pacs = 0.f, pdt = 0.f, pw = 0.f, ptot = 0.f; U4 pxr = {0u, 0u, 0u, 0u}; U4 pcf[4], pcb[4], pbt[4];
#pragma unroll
        for (int k = 0; k < 4; ++k) { pcf[k] = (U4){0u, 0u, 0u, 0u}; pcb[k] = (U4){0u, 0u, 0u, 0u}; pbt[k] = (U4){0u, 0u, 0u, 0u}; }
        const int xrow = (tid >> 1) & 127, xcol = h * 64 + pq * 16 + 8 * (tid & 1);
        const int irow = 16 * wave + il;
#define SCAN_PREF_A(cc) do { const size_t R0_ = (size_t)(cc) * 128; ptot = totp[cc]; \
            pxr = *(const U4*)(XBC + (R0_ + xrow) * 3072 + xcol); pw = WV[dhM + R0_ + xrow]; \
            pacs = ACS2[dhM + R0_ + (tid & 127)]; pdt = DTV[dhM + R0_ + (tid & 127)]; } while (0)
#define SCAN_PREF_B(cc) do { const size_t R0_ = (size_t)(cc) * 128; const size_t cg_ = ((size_t)(cc) * 4 + g) * 128 + irow; \
            _Pragma("unroll") for (int ks = 0; ks < 4; ++ks) { pbt[ks] = *(const U4*)(BT + cg_ * 128 + 32 * ks + 8 * quad); \
                pcf[ks] = *(const U4*)(XBC + (R0_ + irow) * 3072 + 2560 + 128 * g + 32 * ks + 8 * quad); pcb[ks] = *(const U4*)(CB + cg_ * 128 + 32 * ks + 8 * quad); } } while (0)
#define SCAN_STAGE(bsel) do { float* fbb = fb + (bsel) * 400; \
            if (wave < 4) { \
                if (wave < 2) { fbb[tid] = pacs; fbb[128 + tid] = pdt; if (tid == 0) fbb[384] = ptot; } \
                float f_[8]; unpack8(pxr, f_); u16* xt_ = XTb + (bsel) * (2 * 16 * 136); \
                _Pragma("unroll") for (int e = 0; e < 8; ++e) { const unsigned pw_ = pk2(f_[e], f_[e] * pw); xt_[(8 * (tid & 1) + e) * 136 + xrow] = (u16)(pw_ & 0xffffu); xt_[16 * 136 + (8 * (tid & 1) + e) * 136 + xrow] = (u16)(pw_ >> 16); } } } while (0)
        SCAN_PREF_A(scan_chunk(dir, 0)); SCAN_PREF_B(scan_chunk(dir, 0));
        SCAN_STAGE(0);
        SCAN_PREF_A(scan_chunk(dir, 1));
        for (int ci = 0; ci < 130; ++ci) {
            const int c = scan_chunk(dir, ci); const int bsel = ci & 1;
            const size_t R0 = (size_t)c * 128;
            const float* acs = fb + bsel * 400; const float* dtv = acs + 128; const u16* XT = XTb + bsel * (2 * 16 * 136); const u16* XTW = XT + 16 * 136; const u16* HBF = HBFb + bsel * (16 * 136);
            LDS_BAR();
            U4 cf[4], cbv[4], bt[4];
#pragma unroll
            for (int k = 0; k < 4; ++k) { cf[k] = pcf[k]; cbv[k] = pcb[k]; bt[k] = pbt[k]; }
            if (ci + 1 < 130) SCAN_PREF_B(scan_chunk(dir, ci + 1));
            const float tot = acs[384];
            {
                const int i = irow; const float acs_i = acs[i];
                F4 aoffv = {0.f, 0.f, 0.f, 0.f}, acc = {0.f, 0.f, 0.f, 0.f};
#pragma unroll
                for (int ks = 0; ks < 4; ++ks) { const S8 hf = *(const S8*)(HBF + il * 136 + 32 * ks + 8 * quad);
                    aoffv = __builtin_amdgcn_mfma_f32_16x16x32_bf16(__builtin_bit_cast(S8, cf[ks]), hf, aoffv, 0, 0, 0); }
                const int klo = dir == 0 ? 0 : (wave >> 1), khi = dir == 0 ? (wave >> 1) : 3;
#pragma unroll
                for (int ks = 0; ks < 4; ++ks) if (ks >= klo && ks <= khi) {
                    asm volatile("" ::: "memory");
                    float f[8]; unpack8(cbv[ks], f);
                    const int j0 = 32 * ks + 8 * quad;
                    const F4 aj0 = *(const F4*)(acs + j0), aj1 = *(const F4*)(acs + j0 + 4), dj0 = *(const F4*)(dtv + j0), dj1 = *(const F4*)(dtv + j0 + 4);
                    const float aj[8] = {aj0.x, aj0.y, aj0.z, aj0.w, aj1.x, aj1.y, aj1.z, aj1.w}, dj[8] = {dj0.x, dj0.y, dj0.z, dj0.w, dj1.x, dj1.y, dj1.z, dj1.w};
#pragma unroll
                    for (int e = 0; e < 8; ++e) { const int j = j0 + e; const bool ok = dir == 0 ? (j <= i) : (j >= i);
                        f[e] = f[e] * __builtin_amdgcn_exp2f(ok ? acs_i - aj[e] : -INFINITY) * dj[e]; }
                    const U4 gw = pack8(f); const S8 xf = *(const S8*)(XT + il * 136 + 32 * ks + 8 * quad);
                    acc = __builtin_amdgcn_mfma_f32_16x16x32_bf16(__builtin_bit_cast(S8, gw), xf, acc, 0, 0, 0);
                }
                const F4 ar = *(const F4*)(acs + 16 * wave + 4 * quad);
#pragma unroll
                for (int r = 0; r < 4; ++r) { u16* yp = c >= 2 ? Y + (R0 - CTX + 16 * wave + 4 * quad + r) * 2048 + h * 64 + pq * 16 + il : YDUMMY + tid * 4 + r;
                    *yp = (u16)f2bf(acc[r] + __builtin_amdgcn_exp2f(ar[r]) * aoffv[r]); }
            }
            F4 sacc = {0.f, 0.f, 0.f, 0.f};
#pragma unroll
            for (int ks = 0; ks < 4; ++ks) { const S8 xa = *(const S8*)(XTW + il * 136 + 32 * ks + 8 * quad);
                sacc = __builtin_amdgcn_mfma_f32_16x16x32_bf16(xa, __builtin_bit_cast(S8, bt[ks]), sacc, 0, 0, 0); }
            hst = hst * __builtin_amdgcn_exp2f(tot) + sacc;
            if (ci + 1 < 130) { SCAN_STAGE(bsel ^ 1); if (ci + 2 < 130) SCAN_PREF_A(scan_chunk(dir, ci + 2)); }
#pragma unroll
            for (int r = 0; r < 4; ++r) HBFb[(bsel ^ 1) * (16 * 136) + (4 * quad + r) * 136 + 16 * wave + il] = (u16)f2bf(hst[r]);
        }
#undef SCAN_PREF_A
#undef SCAN_PREF_B
#undef SCAN_STAGE
    }
}
constexpr int NPHASES = 38;
enum { K_NONE = 0, K_STORE, K_GM, K_SSDIN, K_SWIGLU, K_RESID };
__device__ __forceinline__ size_t w_fi(int ly) { return ly == 0 ? W_FI0 : ly == 1 ? W_FI1 : ly == 2 ? W_FI2 : W_FI3; }
__device__ __forceinline__ size_t w_fo(int ly) { return ly == 0 ? W_FO0 : ly == 1 ? W_FO1 : ly == 2 ? W_FO2 : W_FO3; }

__device__ __forceinline__ void run_phase(const Args& a, int ph, unsigned char* lds, int bid, int G) {
    unsigned char* ws = a.ws;
    float* X = (float*)(ws + WS_X); u16* H = (u16*)(ws + WS_H); float* MOD = (float*)(ws + WS_MOD);
    unsigned char* outb = (unsigned char*)a.out;
    float* PART = (float*)(ws + WS_PART);
    int kind = K_NONE; const u16* gA = nullptr; const u16* gB = nullptr; int gM = M, gN = 0, gK = 0;
    u16* gdst = nullptr; int gldc = 0; float* gX = X; const float* gl = nullptr; const float* gc = nullptr; int gctx = 1;
    const int ly = ph <= 8 ? 0 : ph <= 16 ? 1 : ph <= 26 ? 2 : 3;
    const float* modL = MOD + (size_t)(ly * 2 + 0) * 6144; const float* modC = MOD + (size_t)(ly * 2 + 1) * 6144;
    const int ffn0 = ly == 0 ? 6 : ly == 1 ? 14 : ly == 2 ? 24 : 34;
    const int n1 = ly == 0 ? 1 : ly == 1 ? 9 : ly == 2 ? 17 : 27;
    const bool latonly = (ly == 3);
    if (ph == 0) { phase_prologue(a, lds, bid, G); }
    else if (ph == n1) {
        if (ly == 0) phase_norm_mod((float*)a.in[I_CTX], a.in[I_X], X, a.in[I_N1G], modL, modC, 0, 1024, H, 0, nullptr, 0, nullptr, bid, G);
        else phase_norm_mod(X, X + (size_t)CTX * D, nullptr, a.in[I_N1G] + ly * D, modL, modC, 0, 1024, H, 0, PART, 11, MOD + (size_t)((ly - 1) * 2 + 1) * 6144 + 5120, bid, G);
    }
    else if (ph == ffn0) { phase_norm_mod(X, X + (size_t)CTX * D, nullptr, a.in[I_N2G] + ly * D, modL, modC, 3072, 4096, H, latonly ? CTX : 0, latonly ? nullptr : PART, ly == 0 ? 8 : 4, modC + 2048, bid, G); }
    else if (ph == ffn0 + 1) { kind = K_SWIGLU; gA = H + (latonly ? (size_t)CTX * D : 0); gB = (const u16*)(ws + w_fi(ly)); gM = latonly ? L : M; gN = 5632; gK = 1024; gdst = (u16*)(ws + B_ACT); }
    else if (ph == ffn0 + 2) { kind = K_RESID; gA = (const u16*)(ws + B_ACT); gB = (const u16*)(ws + w_fo(ly)); gM = latonly ? L : M; gN = 1024; gK = 2816;
        gX = X + (latonly ? (size_t)CTX * D : 0); gl = modL + 5120; gc = modC + 5120; gctx = latonly ? 0 : 1; }
    else switch (ph) {
        case 2: kind = K_GM; gA = H; gB = (const u16*)(ws + W_GMI); gN = 4096; gK = 1024; break;
        case 4: phase_spatial((u16*)(ws + B_U), (const u16*)(ws + B_V), (const float*)(ws + WS_STATSP), a.in[I_GMWS], a.in[I_GMBS], a.in[I_GMLG], a.in[I_GMLB], lds, bid, G); break;
        case 5: kind = K_RESID; gA = (const u16*)(ws + B_U); gB = (const u16*)(ws + W_GMO); gN = 1024; gK = 2048; gl = modL + 2048; gc = modC + 2048; break;
        case 10: kind = K_STORE; gA = H; gB = (const u16*)(ws + W_QKV); gN = 1536; gK = 1024; gdst = (u16*)(ws + B_QKVR); gldc = 1536; break;
        case 11: phase_qk_rope((const u16*)(ws + B_QKVR), a.in[I_ATQG], a.in[I_ATKG], (u16*)(ws + B_Q), (u16*)(ws + B_K), (u16*)(ws + B_VV), bid, G); break;
        case 12: phase_attention((const u16*)(ws + B_Q), (const u16*)(ws + B_K), (const u16*)(ws + B_VV), (u16*)(ws + B_QKVR), lds, bid, G); break;
        case 13: kind = K_RESID; gA = (const u16*)(ws + B_QKVR); gB = (const u16*)(ws + W_ATO); gN = 1024; gK = 1024; gl = modL + 2048; gc = modC + 2048; break;
        case 18: kind = K_STORE; gA = H; gB = (const u16*)(ws + W_HYI); gN = 3072; gK = 1024; gdst = (u16*)(ws + B_P); gldc = 3072; break;
        case 19: phase_hy_dwconv((const u16*)(ws + B_P), a.in[I_HYCW], a.in[I_HYCB], (u16*)(ws + B_X0), (u16*)(ws + B_UT), lds, bid, G); break;
        case 21: phase_hy_conv((const u16*)(outb + OUT_KK), (const u16*)(ws + B_UT), (u16*)(ws + B_YT), (const float*)(ws + WS_HID2), a.in[I_HYW3], a.in[I_HYSK], lds, bid, G); break;
        case 22: phase_hy_tgate((u16*)(ws + B_X0), (const u16*)(ws + B_YT), lds, bid, G); break;
        case 23: kind = K_RESID; gA = (const u16*)(ws + B_X0); gB = (const u16*)(ws + W_HYO); gN = 1024; gK = 1024; gl = modL + 2048; gc = modC + 2048; break;
        case 28: kind = K_SSDIN; gA = H; gB = (const u16*)(ws + W_SSI); gN = 5376; gK = 1024; break;
        case 29: phase_ssd_conv((u16*)(ws + B_XBC), (const u16*)(outb + OUT_HALO), a.in[I_SSCW], a.in[I_SSCB], bid, G); break;
        case 30: phase_ssd_cb((const u16*)(ws + B_XBC), (u16*)(ws + WS_CB), (u16*)(ws + WS_BT), (const float*)(ws + B_DT), a.in[I_SSAL], a.in[I_SSDB], (float*)(ws + WS_ACS2), (float*)(ws + WS_DTV), (float*)(ws + WS_WV), (float*)(ws + WS_TOT), lds, bid, G); break;
        case 31: phase_ssd_scan((const u16*)(ws + B_XBC), (const float*)(ws + WS_ACS2), (const float*)(ws + WS_DTV), (const float*)(ws + WS_WV), (const float*)(ws + WS_TOT), (const u16*)(ws + WS_CB), (const u16*)(ws + WS_BT), (u16*)(ws + WS_YF), (u16*)outb, (u16*)(ws + 16384), lds, bid, G); break;
        case 32: phase_ssd_finish((const u16*)(ws + WS_YF), (const u16*)outb, (const u16*)(ws + B_XBC), (u16*)(ws + B_Z), a.in[I_SSDS], a.in[I_SSNG], bid, G); break;
        case 33: kind = K_RESID; gA = (const u16*)(ws + B_Z) + (size_t)CTX * 2048; gB = (const u16*)(ws + W_SSO); gM = L; gN = 1024; gK = 2048; gX = X + (size_t)CTX * D; gl = modL + 2048; gc = modC + 2048; gctx = 0; break;
        case 37: phase_final(X, a.in[I_FING], a.out, bid, G); break;
        default: break;
    }
    if (kind != K_NONE) {
        const bool split = (kind == K_RESID) && gctx;
        if (split) { gA += (size_t)CTX * gK; gM = L; gX = X + (size_t)CTX * D; gctx = 0; }
        pg8::Gemm g{gA, gB, gM, gN, gK, gK}; pg8::StaticOrder S; S.init(gM, gN, G, bid);
        PG8_LAS unsigned char* l3 = (PG8_LAS unsigned char*)lds;
        if (kind == K_STORE) { pg8::EpiStore<0, pg8::RouterSimple> E{pg8::RouterSimple{gdst, gldc}}; pg8::gemm_phase<pg8::EpiStore<0, pg8::RouterSimple>, pg8::StaticOrder, true, true>(l3, g, S, E);
            if (ph == 10 && bid >= 134) convert_layer(a, 3, lds, bid - 134, G - 134);
            if (ph == 18) phase_hy_ktgen((const float*)(ws + WS_HID2), a.in[I_HYW3], a.in[I_HYSK], (u16*)(outb + OUT_KK), lds, bid, G); }
        else if (kind == K_GM) { pg8::EpiGmIn E{(u16*)(ws + B_U), (u16*)(ws + B_V), (float*)(ws + WS_STATSP)}; pg8::gemm_phase<pg8::EpiGmIn, pg8::StaticOrder, true, true>(l3, g, S, E);
            if (bid >= 16) convert_layer(a, 1, lds, bid - 16, G - 16); }
        else if (kind == K_SSDIN) { pg8::EpiSsdIn E{(u16*)(ws + B_Z), (u16*)(ws + B_XBC), (float*)(ws + B_DT), (u16*)(outb + OUT_HALO)}; pg8::gemm_phase<pg8::EpiSsdIn, pg8::StaticOrder, true, true>(l3, g, S, E); }
        else if (kind == K_SWIGLU) { pg8::EpiSwiglu E{gdst}; pg8::gemm_phase<pg8::EpiSwiglu, pg8::StaticOrder, true, true>(l3, g, S, E);
            if (ph == 7 && bid >= 150) convert_layer(a, 2, lds, bid - 150, G - 150); }
        else {
            if (split) { pg8::Gemm g2{gA - (size_t)CTX * gK, gB, CTX, gN, gK, 256}; pg8::SplitKOrder S2; S2.init(gN, gK / 256, G, bid); pg8::EpiPartial E2{PART};
                pg8::gemm_phase<pg8::EpiPartial, pg8::SplitKOrder, false, true>(l3, g2, S2, E2);
                __builtin_amdgcn_sched_barrier(0); }
            pg8::EpiResid E{gX, gl, gc, gctx}; pg8::gemm_phase<pg8::EpiResid, pg8::StaticOrder, true, true>(l3, g, S, E); }
    }
}

#define XB_TMO      128
#define XB_XCNT(j)  (256  + 64 * (j))
#define XB_XSUB(j)  (1280 + 64 * (j))
#define XB_XGEN(j)  (2304 + 64 * (j))
#define XB_TOP      3328
#define XB_TOPGEN   3392
#define XCD_BAR_WORDS 3456
#define XB_SPIN_CAP (1u << 18)

__device__ __forceinline__ unsigned xb_ld(unsigned* p)              { return __hip_atomic_load(p, __ATOMIC_RELAXED, __HIP_MEMORY_SCOPE_AGENT); }
__device__ __forceinline__ unsigned xb_add(unsigned* p, unsigned v) { return __hip_atomic_fetch_add(p, v, __ATOMIC_RELAXED, __HIP_MEMORY_SCOPE_AGENT); }
__device__ __forceinline__ unsigned xb_xcc_id() { return (unsigned)__builtin_amdgcn_s_getreg((3 << 11) | 20) & 0xFu; }
#define XB_SPIN(cond, bar) do { unsigned _sp = 0; while (cond) { __builtin_amdgcn_s_sleep(1); \
    if ((++_sp & 255u) == 0u) { if (xb_ld(&(bar)[XB_TMO])) break; if (_sp > XB_SPIN_CAP) { atomicAdd(&(bar)[XB_TMO], 1u); break; } } } } while (0)

struct XcdBarrier {
    unsigned* bar; unsigned x;
    volatile LAS unsigned* st;
};

__device__ __forceinline__ XcdBarrier xcd_barrier_post(unsigned* bar, volatile LAS unsigned* st) {
    XcdBarrier b; b.bar = bar; b.x = xb_xcc_id(); b.st = st;
    if (TIDX() == 0) (void)xb_add(&bar[XB_XCNT(b.x)], 1u);
    return b;
}
__device__ __forceinline__ void xcd_barrier_complete(unsigned* bar, unsigned x, unsigned& nloc, unsigned& nx) {
    const unsigned G = gridDim.x * gridDim.y * gridDim.z;
    unsigned sum, cnt, mine, sp = 0u;
    for (;;) {
        sum = 0u; cnt = 0u; mine = 0u;
#pragma unroll
        for (unsigned j = 0; j < 16; ++j) { const unsigned c = xb_ld(&bar[XB_XCNT(j)]); sum += c; cnt += (c > 0u) ? 1u : 0u; mine = (j == x) ? c : mine; }
        if (sum == G) break;
        __builtin_amdgcn_s_sleep(1);
        if ((++sp & 255u) == 0u) { if (xb_ld(&bar[XB_TMO])) break; if (sp > XB_SPIN_CAP) { atomicAdd(&bar[XB_TMO], 1u); break; } }
    }
    nloc = mine > 0u ? mine : 1u; nx = cnt > 0u ? cnt : 1u;
}

__device__ __forceinline__ void xcd_barrier(const XcdBarrier& b) {
    asm volatile("s_waitcnt vmcnt(0)" ::: "memory");
    __syncthreads();
    if (TIDX() == 0) {
        unsigned* bar = b.bar;
        __builtin_amdgcn_s_waitcnt(0);
        unsigned nloc = b.st[0], nx = b.st[1];
        if (nloc == 0u) { xcd_barrier_complete(bar, b.x, nloc, nx); b.st[0] = nloc; b.st[1] = nx; }
        const unsigned old = xb_add(&bar[XB_XSUB(b.x)], 1u);
        const unsigned gen = old / nloc;
        if (old + 1u == (gen + 1u) * nloc) {
            __builtin_amdgcn_fence(__ATOMIC_RELEASE, "agent");
            asm volatile("s_waitcnt vmcnt(0)" ::: "memory");
            const unsigned og = xb_add(&bar[XB_TOP], 1u);
            const unsigned tg = og / nx;
            if (og + 1u == (tg + 1u) * nx) xb_add(&bar[XB_TOPGEN], 1u);
            else XB_SPIN(xb_ld(&bar[XB_TOPGEN]) == tg, bar);
            __builtin_amdgcn_fence(__ATOMIC_ACQUIRE, "agent");
            xb_add(&bar[XB_XGEN(b.x)], 1u);
            asm volatile("s_waitcnt vmcnt(0)" ::: "memory");
        } else {
            XB_SPIN(xb_ld(&bar[XB_XGEN(b.x)]) == gen, bar);
            __builtin_amdgcn_fence(__ATOMIC_ACQUIRE, "agent");
            asm volatile("s_waitcnt vmcnt(0)" ::: "memory");
        }
    }
    __syncthreads();
}


#if MK_MULTI_LAUNCH
template <int PH> __global__ void __launch_bounds__(NTHR, 2) k_phase(Args a) {
    extern __shared__ __attribute__((aligned(16))) unsigned char lds[];
    run_phase(a, PH, lds, blockIdx.x, gridDim.x);
}
typedef void (*phase_kernel_t)(Args);
template <int... I> static void fill_table(phase_kernel_t* t, std::integer_sequence<int, I...>) { ((t[I] = k_phase<I>), ...); }
#define MEGA_K k_phase<0>
#else
typedef const __attribute__((address_space(4))) Args* kargs_t;
constexpr int MISC_OFF = LDS_BYTES - 128;
template <int PH> __device__ __forceinline__ void run_from(unsigned char* lds, const XcdBarrier& bar) {
    if constexpr (PH == 3 || PH == 20) { run_from<PH + 1>(lds, bar); }
    else if constexpr (PH < NPHASES) {
        {
#if defined(__HIP_DEVICE_COMPILE__)
            kargs_t ap = (kargs_t)__builtin_amdgcn_kernarg_segment_ptr();
            asm volatile("" : "+s"(ap));
            Args la;
            for (int i = 0; i < 40; ++i) la.in[i] = ap->in[i];
            la.out = ap->out; la.ws = ap->ws; la.ph_lo = 0; la.ph_hi = NPHASES;
            run_phase(la, PH, lds, blockIdx.x, gridDim.x);
#if defined(PROBE_REPEAT)
            if constexpr (PROBE_REPEAT(PH)) { xcd_barrier(bar); run_phase(la, PH, lds, blockIdx.x, gridDim.x); }
#endif
#endif
        }
        if constexpr (PH + 1 < NPHASES) {
            if constexpr (PH == 0) cg::this_grid().sync(); else xcd_barrier(bar);
            run_from<PH + 1>(lds, bar);
        }
    }
}
__global__ void __launch_bounds__(NTHR, 2) mega_fwd(Args a) {
    extern __shared__ __attribute__((aligned(16))) unsigned char lds[];
    volatile LAS unsigned* misc = (volatile LAS unsigned*)((LAS unsigned char*)lds + MISC_OFF);
    if (TIDX() < 32) misc[TIDX()] = 0u;
    if (blockIdx.x == 0) { unsigned* bw = (unsigned*)a.ws; for (int i = TIDX(); i < XCD_BAR_WORDS; i += NTHR) bw[i] = 0u; }
    __syncthreads();
    {
#if defined(__HIP_DEVICE_COMPILE__)
        kargs_t ap = (kargs_t)__builtin_amdgcn_kernarg_segment_ptr();
        asm volatile("" : "+s"(ap));
        Args la;
        for (int i = 0; i < 40; ++i) la.in[i] = ap->in[i];
        la.out = ap->out; la.ws = ap->ws; la.ph_lo = 0; la.ph_hi = NPHASES;
        run_phase(la, 0, lds, blockIdx.x, gridDim.x);
#endif
    }
    cg::this_grid().sync();
    const XcdBarrier bar = xcd_barrier_post((unsigned*)a.ws, misc + 8);
    run_from<1>(lds, bar);
}
#define MEGA_K mega_fwd
#endif

extern "C" void kernel_launch(void* const* d_in, const int* in_sizes, int n_in, void* d_out, int out_size, void* d_ws, size_t ws_size, hipStream_t stream) {
    static int grid = 0;
    if (grid == 0) {
        if (n_in != 40 || out_size != L * D || ws_size < WS_END) { fprintf(stderr, "kernel_launch: unexpected shapes (n_in %d, out %d, ws %zu, need %zu)\n", n_in, out_size, ws_size, (size_t)WS_END); grid = -1; return; }
        int dev = 0, cus = 0, per_cu = 0;
        (void)hipGetDevice(&dev); (void)hipDeviceGetAttribute(&cus, hipDeviceAttributeMultiprocessorCount, dev);
        if (hipFuncSetAttribute((const void*)MEGA_K, hipFuncAttributeMaxDynamicSharedMemorySize, LDS_BYTES) != hipSuccess) { fprintf(stderr, "kernel_launch: hipFuncSetAttribute failed\n"); grid = -1; return; }
        if (hipOccupancyMaxActiveBlocksPerMultiprocessor(&per_cu, (const void*)MEGA_K, NTHR, LDS_BYTES) != hipSuccess || per_cu < 1) per_cu = 1;
        (void)hipGetLastError();
        grid = cus * per_cu;
        if (grid <= 0) grid = 256;
    }
    if (grid < 0) return;
    Args a{};
    for (int i = 0; i < 40; ++i) a.in[i] = (const float*)d_in[i];
    a.out = (float*)d_out; a.ws = (unsigned char*)d_ws;
#if MK_MULTI_LAUNCH
    static phase_kernel_t table[NPHASES]; static bool tinit = false;
    if (!tinit) { fill_table(table, std::make_integer_sequence<int, NPHASES>{}); for (int ph = 0; ph < NPHASES; ++ph) (void)hipFuncSetAttribute((const void*)table[ph], hipFuncAttributeMaxDynamicSharedMemorySize, LDS_BYTES); tinit = true; }
    for (int ph = 0; ph < NPHASES; ++ph) { a.ph_lo = ph; a.ph_hi = ph + 1; hipLaunchKernelGGL(table[ph], dim3(grid), dim3(NTHR), LDS_BYTES, stream, a); }
#else
    a.ph_lo = 0; a.ph_hi = NPHASES;
    void* args[] = {&a};
    hipError_t e = hipLaunchCooperativeKernel((const void*)mega_fwd, dim3(grid), dim3(NTHR), args, LDS_BYTES, stream);
    if (e != hipSuccess) fprintf(stderr, "cooperative launch failed: %s (grid %d)\n", hipGetErrorString(e), grid);
#endif
}
```
